# Optimizing an MI355X kernel written in HIP

```python
import jax, jax.numpy as jnp
from jax import lax
import numpy as np

D_MODEL = 1024
BATCH = 4
SEQ = 4096
DEPTH = 1

CTX_LEN = 256
GRID_W = 64
D_INNER = 2 * D_MODEL
W_POOL = D_INNER // 2
W_SSD = D_INNER - W_POOL
POOL_WINDOWS = (2, 4, 8, 16)
N_POOL_GROUPS = len(POOL_WINDOWS)
POOL_GROUP_W = W_POOL // N_POOL_GROUPS
SSD_HEADDIM = 64
SSD_HEADS = W_SSD // SSD_HEADDIM
SSD_GROUPS = 4
SSD_HEADS_PER_GROUP = SSD_HEADS // SSD_GROUPS
D_STATE = 128
D_CONV = 4
CONV_LEFT = D_CONV // 2
CHUNK = 128
N_DIR = 2
GN = SSD_GROUPS * D_STATE
CONV_DIM = W_SSD + 2 * GN
OFF_POOL_Z = W_POOL
OFF_SSD_Z = 2 * W_POOL
OFF_XBC = 2 * W_POOL + W_SSD
OFF_DT = OFF_XBC + CONV_DIM
PROJ_DIM = OFF_DT + N_DIR * SSD_HEADS
EPS = 1e-6

kernel_name = "hybrid_pool_ssd_prefix_dit_block"


def rmsnorm(x, w):
    xf = x.astype(jnp.float32)
    y = xf * lax.rsqrt(jnp.mean(xf * xf, axis=-1, keepdims=True) + EPS)
    return (y * w.astype(jnp.float32)).astype(x.dtype)


def box_mean(x, window, axis):
    n = x.shape[axis]
    s = jnp.cumsum(x.astype(jnp.float32), axis=axis)
    pad = [(0, 0)] * x.ndim
    pad[axis] = (1, 0)
    s = jnp.pad(s, pad)
    t = jnp.arange(n)
    lo = jnp.clip(t - window // 2, 0, n)
    hi = jnp.clip(t + window - window // 2, 0, n)
    total = jnp.take(s, hi, axis=axis) - jnp.take(s, lo, axis=axis)
    shape = [1] * x.ndim
    shape[axis] = n
    count = (hi - lo).astype(jnp.float32).reshape(shape)
    return (total / count).astype(x.dtype)


def pool_mixer(u, w_lin, scale, grid):
    b, n, _ = u.shape
    groups = u.reshape(b, n, N_POOL_GROUPS, POOL_GROUP_W)
    outs = []
    for g, w in enumerate(POOL_WINDOWS):
        ug = groups[:, :, g]
        if grid:
            rows = n // GRID_W
            img = ug.reshape(b, rows, GRID_W, POOL_GROUP_W)
            m = box_mean(box_mean(img, w, 1), w, 2).reshape(b, n, POOL_GROUP_W)
        else:
            m = box_mean(ug, w, 1)
        outs.append(m - ug)
    d = jnp.stack(outs, axis=2)
    y = jnp.einsum('bngc,gcd->bngd', d, w_lin).reshape(b, n, W_POOL)
    return y * scale


def centred_dwconv(u, w, bias):
    n = u.shape[1]
    up = jnp.pad(u, ((0, 0), (CONV_LEFT, D_CONV - 1 - CONV_LEFT), (0, 0)))
    y = sum(up[:, k:k + n] * w[k] for k in range(D_CONV))
    return jax.nn.silu(y + bias)


def ssd_scan(x, dt, a, b_in, c_in, h0):
    bsz, n = x.shape[:2]
    nc = n // CHUNK
    G, R = SSD_GROUPS, SSD_HEADS_PER_GROUP
    xd = (x * dt[..., None]).reshape(bsz, nc, CHUNK, G, R, SSD_HEADDIM)
    adt = (dt * a).reshape(bsz, nc, CHUNK, G, R)
    bc = b_in.reshape(bsz, nc, CHUNK, G, D_STATE)
    cc = c_in.reshape(bsz, nc, CHUNK, G, D_STATE)
    acum = jnp.cumsum(adt, axis=2)
    seg = acum[:, :, :, None] - acum[:, :, None, :]
    lower = jnp.tril(jnp.ones((CHUNK, CHUNK), dtype=bool))[:, :, None, None]
    decay = jnp.exp(jnp.where(lower, seg, -jnp.inf))
    cb = jnp.einsum('bclgn,bcsgn->bclsg', cc, bc)
    y_diag = jnp.einsum('bclsg,bclsgr,bcsgrp->bclgrp', cb, decay, xd)
    decay_to_end = jnp.exp(acum[:, :, -1:] - acum)
    chunk_states = jnp.einsum('bclgn,bclgr,bclgrp->bcgrpn', bc, decay_to_end, xd)
    chunk_decay = jnp.exp(acum[:, :, -1])

    def step(h, inp):
        s_c, d_c = inp
        return h * d_c[..., None, None] + s_c, h

    h_final, h_starts = lax.scan(
        step, h0, (jnp.moveaxis(chunk_states, 1, 0), jnp.moveaxis(chunk_decay, 1, 0)))
    h_starts = jnp.moveaxis(h_starts, 0, 1)
    y_off = jnp.einsum('bclgn,bcgrpn,bclgr->bclgrp', cc, h_starts, jnp.exp(acum))
    y = (y_diag + y_off).reshape(bsz, n, SSD_HEADS, SSD_HEADDIM)
    return y, h_final


def ssd_bidir(xbc_raw, dt_raw, conv_w, conv_b, a_log, dt_bias, d_skip, h0):
    bsz, n, _ = xbc_raw.shape
    xbc = centred_dwconv(xbc_raw, conv_w, conv_b)
    xs = xbc[..., :W_SSD].reshape(bsz, n, SSD_HEADS, SSD_HEADDIM)
    bs = xbc[..., W_SSD:W_SSD + GN].reshape(bsz, n, SSD_GROUPS, D_STATE)
    cs = xbc[..., W_SSD + GN:].reshape(bsz, n, SSD_GROUPS, D_STATE)
    dt = jax.nn.softplus(dt_raw.reshape(bsz, n, N_DIR, SSD_HEADS).astype(jnp.float32)
                         + dt_bias.astype(jnp.float32))
    a = -jnp.exp(a_log.astype(jnp.float32))
    flip = lambda t: jnp.flip(t, axis=1)
    y_f, h_f = ssd_scan(xs, dt[:, :, 0], a[0], bs, cs, h0[0])
    y_b, h_b = ssd_scan(flip(xs), flip(dt[:, :, 1]), a[1], flip(bs), flip(cs), h0[1])
    y = y_f + flip(y_b) + d_skip[:, None] * xs
    return y.reshape(bsz, n, W_SSD).astype(xbc_raw.dtype), jnp.stack([h_f, h_b])


def modulated_projection(h, norm_w, shift, scale, w_in):
    hm = rmsnorm(h, norm_w) * (1.0 + scale) + shift
    return hm @ w_in


def mixer_output(p, y_ssd, grid, pool_w, pool_scale, ssd_norm_w, w_out):
    bsz, n, _ = p.shape
    u_pool = p[..., :W_POOL]
    z_pool = p[..., OFF_POOL_Z:OFF_SSD_Z]
    z_ssd = p[..., OFF_SSD_Z:OFF_XBC]
    y_pool = pool_mixer(u_pool, pool_w, pool_scale, grid) * jax.nn.silu(z_pool)
    gated = (y_ssd * jax.nn.silu(z_ssd)).reshape(bsz, n, SSD_GROUPS, W_SSD // SSD_GROUPS)
    y_s = rmsnorm(gated, ssd_norm_w.reshape(SSD_GROUPS, W_SSD // SSD_GROUPS)).reshape(bsz, n, W_SSD)
    return jnp.concatenate([y_pool, y_s], axis=-1) @ w_out


def setup_inputs(seed: int = 0) -> dict:
    key = jax.random.key(seed)
    ks = jax.random.split(key, 20)
    nrm = jax.random.normal
    x = nrm(ks[0], (BATCH, SEQ, D_MODEL), jnp.float32)
    c = nrm(ks[1], (BATCH, D_MODEL), jnp.float32)
    ctx = nrm(ks[2], (BATCH, CTX_LEN, D_MODEL), jnp.float32)
    c_ctx = nrm(ks[3], (D_MODEL,), jnp.float32)
    norm_w = 1.0 + 0.02 * nrm(ks[4], (DEPTH, D_MODEL), jnp.float32)
    w_ada = 0.5 * D_MODEL ** -0.5 * nrm(ks[5], (DEPTH, D_MODEL, 3 * D_MODEL), jnp.float32)
    b_ada = 0.02 * nrm(ks[6], (DEPTH, 3 * D_MODEL), jnp.float32)
    w_in = D_MODEL ** -0.5 * nrm(ks[7], (DEPTH, D_MODEL, PROJ_DIM), jnp.float32)
    conv_w = D_CONV ** -0.5 * nrm(ks[8], (DEPTH, D_CONV, CONV_DIM), jnp.float32)
    conv_b = 0.02 * nrm(ks[9], (DEPTH, CONV_DIM), jnp.float32)
    a_log = jnp.log(jax.random.uniform(ks[10], (DEPTH, N_DIR, SSD_HEADS), jnp.float32, 1.0, 16.0))
    dt0 = jnp.exp(jax.random.uniform(ks[11], (DEPTH, N_DIR, SSD_HEADS), jnp.float32,
                                     float(np.log(1e-3)), float(np.log(1e-1))))
    dt_bias = dt0 + jnp.log(-jnp.expm1(-dt0))
    d_skip = 1.0 + 0.02 * nrm(ks[12], (DEPTH, SSD_HEADS), jnp.float32)
    ssd_norm_w = 1.0 + 0.02 * nrm(ks[13], (DEPTH, W_SSD), jnp.float32)
    pool_w = POOL_GROUP_W ** -0.5 * nrm(ks[14], (DEPTH, N_POOL_GROUPS, POOL_GROUP_W, POOL_GROUP_W), jnp.float32)
    pool_scale = 1.0 + 0.02 * nrm(ks[15], (DEPTH, W_POOL), jnp.float32)
    w_out = D_INNER ** -0.5 * nrm(ks[16], (DEPTH, D_INNER, D_MODEL), jnp.float32)
    final_norm_w = 1.0 + 0.02 * nrm(ks[17], (D_MODEL,), jnp.float32)
    return {"x": x, "c": c, "ctx": ctx, "c_ctx": c_ctx, "norm_w": norm_w,
            "w_ada": w_ada, "b_ada": b_ada, "w_in": w_in, "conv_w": conv_w,
            "conv_b": conv_b, "a_log": a_log, "dt_bias": dt_bias, "d_skip": d_skip,
            "ssd_norm_w": ssd_norm_w, "pool_w": pool_w, "pool_scale": pool_scale,
            "w_out": w_out, "final_norm_w": final_norm_w}


def reference(x, c, ctx, c_ctx, norm_w, w_ada, b_ada, w_in, conv_w, conv_b, a_log,
              dt_bias, d_skip, ssd_norm_w, pool_w, pool_scale, w_out, final_norm_w):
    bsz = x.shape[0]
    h_lat, h_ctx = x, ctx
    for i in range(DEPTH):
        mod_lat = jax.nn.silu(c) @ w_ada[i] + b_ada[i]
        mod_ctx = jax.nn.silu(c_ctx) @ w_ada[i] + b_ada[i]
        sh_l, sc_l, g_l = jnp.split(mod_lat[:, None, :], 3, axis=-1)
        sh_c, sc_c, g_c = jnp.split(mod_ctx, 3, axis=-1)

        p_ctx = modulated_projection(h_ctx, norm_w[i], sh_c, sc_c, w_in[i])
        h0 = jnp.zeros((N_DIR, bsz, SSD_GROUPS, SSD_HEADS_PER_GROUP, SSD_HEADDIM, D_STATE), jnp.float32)
        y_ssd_ctx, h_ctx_end = ssd_bidir(p_ctx[..., OFF_XBC:OFF_DT], p_ctx[..., OFF_DT:],
                                         conv_w[i], conv_b[i], a_log[i], dt_bias[i], d_skip[i], h0)

        p_lat = modulated_projection(h_lat, norm_w[i], sh_l, sc_l, w_in[i])
        y_ssd_lat, _ = ssd_bidir(p_lat[..., OFF_XBC:OFF_DT], p_lat[..., OFF_DT:],
                                 conv_w[i], conv_b[i], a_log[i], dt_bias[i], d_skip[i], h_ctx_end)
        h_lat = h_lat + g_l * mixer_output(p_lat, y_ssd_lat, True, pool_w[i], pool_scale[i],
                                           ssd_norm_w[i], w_out[i])
        if i < DEPTH - 1:
            h_ctx = h_ctx + g_c * mixer_output(p_ctx, y_ssd_ctx, False, pool_w[i], pool_scale[i],
                                               ssd_norm_w[i], w_out[i])
    return rmsnorm(h_lat, final_norm_w)
```

```cpp
#include <hip/hip_runtime.h>
#include <hip/hip_cooperative_groups.h>
#include <cstdio>
#include <cstdint>
namespace cg = cooperative_groups;
namespace pg8 {
#define PG8_LAS __attribute__((address_space(3)))
typedef unsigned short bf16_t;
typedef short bf16x8 __attribute__((ext_vector_type(8)));
typedef float f32x4 __attribute__((ext_vector_type(4)));
typedef unsigned u32x4 __attribute__((ext_vector_type(4)));
constexpr int BM = 256, BK = 64, HALF = 128, HTB = HALF * BK * 2  , STAGE_BYTES = 8 * HTB, NXCD = 8, WGM = 8;

__host__ __device__ __forceinline__ int lds_byte(int r, int c) { const int st = (r >> 4) * 2 + (c >> 5), rr = r & 15, cc = c & 31, ob = rr * 64 + cc * 2; return st * 1024 + (ob ^ (((ob >> 9) & 1) << 5)); }
__host__ __device__ __forceinline__ void stage_rc(int b, int& R, int& C) { const int st = b / 1024, sb = b % 1024, swz = sb ^ (((sb >> 9) & 1) << 5); R = (st >> 1) * 16 + swz / 64; C = (st & 1) * 32 + (swz % 64) / 2; }
__host__ __device__ __forceinline__ int perm32(int rho) { const int n = rho >> 4, i = rho & 15; return 8 * (i >> 2) + 4 * n + (i & 3); }

struct Unit { int pm, pn; };
struct Gemm { const bf16_t* A; const bf16_t* Bt; int M, N, K; };

struct StaticOrder {
    int nM, nN, nwg, G, c;
    __host__ __device__ void init(int M, int N, int G_, int c_) { nM = M / BM; nN = N / BM; nwg = nM * nN; G = G_; c = c_; }
    __host__ __device__ bool next(int i, Unit& u) const {
        const long L = (long)i * G + c; if (L >= nwg) return false;
        int wgid = (int)L; { const int q = nwg / NXCD, r = nwg % NXCD, xcd = wgid % NXCD, off = wgid / NXCD; wgid = (xcd < r ? xcd * (q + 1) : r * (q + 1) + (xcd - r) * q) + off; }
        const int nig = WGM * nN, gid = wgid / nig, fm = gid * WGM, gsz = (nM - fm) < WGM ? (nM - fm) : WGM;
        u.pm = fm + ((wgid % nig) % gsz); u.pn = (wgid % nig) / gsz; return true;
    }
    __device__ __forceinline__ void a_ready(const Unit&) const {}
    __device__ __forceinline__ void done(const Unit&) const {}
};

__device__ __forceinline__ unsigned cvt_pk_bf16(float lo, float hi) { unsigned r; asm volatile("v_cvt_pk_bf16_f32 %0, %1, %2" : "=v"(r) : "v"(lo), "v"(hi)); return r; }
template <class Epi, class Sched, bool ALIGN_EPI = false, bool SP2 = false>
__device__ __forceinline__ void gemm_phase(PG8_LAS unsigned char* lds, const Gemm g, const Sched& S, const Epi& E) {
    const int tid = threadIdx.x, wid = __builtin_amdgcn_readfirstlane(tid >> 6), lane = tid & 63, wr = wid >> 2, wc = wid & 3, fr = lane & 15, fq = lane >> 4;
    const int K = g.K, nt = K / BK;
    unsigned voffA[2], voffB[2];
#pragma unroll
    for (int i = 0; i < 2; ++i) { int R, C; stage_rc(tid * 16 + i * 8192, R, C); const int Rb = Epi::PERM ? ((R & ~31) + perm32(R & 31)) : R;
        voffA[i] = (unsigned)(R * K + C) * 2u; voffB[i] = (unsigned)(Rb * K + C) * 2u; }
    const size_t kstep = (size_t)(BK * 2);
    const size_t hstep = (size_t)HALF * K * 2;
    const size_t tstep = 2 * hstep;
    const unsigned ldsw = (unsigned)wid * 1024u;
    const int aoff = lds_byte(wr * 64 + fr, fq * 8), boff = lds_byte(wc * 32 + fr, fq * 8);
#define PG8_SA(b, h) (((b) * 2 + (h)) * HTB)
#define PG8_SB(b, h) ((4 + (b) * 2 + (h)) * HTB)
#define PG8_STAGE(bufoff, gbase, voff) do { _Pragma("unroll") for (int _i = 0; _i < 2; ++_i) \
        __builtin_amdgcn_global_load_lds((const unsigned*)((const char*)(gbase) + (voff)[_i]), (PG8_LAS unsigned*)(lds + (bufoff) + ldsw + _i * 8192), 16, 0, 0); } while (0)
#define PG8_LDA(dst, b, h) do { _Pragma("unroll") for (int m = 0; m < 4; ++m) _Pragma("unroll") for (int k = 0; k < 2; ++k) dst[m][k] = *(const PG8_LAS bf16x8*)(lds + PG8_SA(b, h) + aoff + m * 2048 + k * 1024); } while (0)
#define PG8_LDB(dst, b, h) do { _Pragma("unroll") for (int n = 0; n < 2; ++n) _Pragma("unroll") for (int k = 0; k < 2; ++k) dst[n][k] = *(const PG8_LAS bf16x8*)(lds + PG8_SB(b, h) + boff + n * 2048 + k * 1024); } while (0)
#define PG8_MMA(ai, bj, At, Bt) do { __builtin_amdgcn_s_setprio(1); _Pragma("unroll") for (int m = 0; m < 4; ++m) _Pragma("unroll") for (int n = 0; n < 2; ++n) _Pragma("unroll") for (int k = 0; k < 2; ++k) \
        acc[ai][bj][m][n] = __builtin_amdgcn_mfma_f32_16x16x32_bf16(Bt[n][k], At[m][k], acc[ai][bj][m][n], 0, 0, 0); __builtin_amdgcn_s_setprio(0); } while (0)
#define PG8_WAIT_V(n) asm volatile("s_waitcnt vmcnt(" #n ")" ::: "memory")
#define PG8_WAIT_L(n) asm volatile("s_waitcnt lgkmcnt(" #n ")" ::: "memory")
#define PG8_BAR __builtin_amdgcn_s_barrier()
#define PG8_SCHED __builtin_amdgcn_sched_barrier(0)
    Unit cur, nxt; int ui = 0;
    if (!S.next(0, cur)) return;
    f32x4 acc[2][2][4][2];
#pragma unroll
    for (int a = 0; a < 2; ++a)
#pragma unroll
        for (int b = 0; b < 2; ++b)
#pragma unroll
            for (int m = 0; m < 4; ++m)
#pragma unroll
                for (int n = 0; n < 2; ++n) acc[a][b][m][n] = (f32x4){0.f, 0.f, 0.f, 0.f};
    bf16x8 At[4][2], B0[2][2], B1[2][2];
    const char* cA = (const char*)g.A + (size_t)cur.pm * tstep; const char* cB = (const char*)g.Bt + (size_t)cur.pn * tstep;
    S.a_ready(cur);
    if constexpr (SP2) {
        PG8_STAGE(PG8_SB(0, 0), cB, voffB); PG8_STAGE(PG8_SB(0, 1), cB + hstep, voffB); PG8_STAGE(PG8_SA(0, 0), cA, voffA); PG8_STAGE(PG8_SA(0, 1), cA + hstep, voffA);
        if (wr == 1) PG8_BAR;
        PG8_WAIT_V(2); PG8_BAR;
        PG8_STAGE(PG8_SB(1, 0), cB + kstep, voffB); PG8_STAGE(PG8_SA(1, 0), cA + kstep, voffA); PG8_STAGE(PG8_SB(1, 1), cB + hstep + kstep, voffB);
        PG8_WAIT_V(6); PG8_BAR;
    } else {
        PG8_STAGE(PG8_SB(0, 0), cB, voffB); PG8_STAGE(PG8_SA(0, 0), cA, voffA); PG8_STAGE(PG8_SB(0, 1), cB + hstep, voffB); PG8_STAGE(PG8_SA(0, 1), cA + hstep, voffA);
        if (wr == 1) PG8_BAR;
        PG8_WAIT_V(4); PG8_BAR;
        PG8_STAGE(PG8_SB(1, 0), cB + kstep, voffB); PG8_STAGE(PG8_SA(1, 0), cA + kstep, voffA); PG8_STAGE(PG8_SB(1, 1), cB + hstep + kstep, voffB);
        PG8_WAIT_V(6); PG8_BAR;
    }
    for (;;) {
        const bool has_next = S.next(ui + 1, nxt);
        const char* nA = has_next ? (const char*)g.A + (size_t)nxt.pm * tstep : cA; const char* nB = has_next ? (const char*)g.Bt + (size_t)nxt.pn * tstep : cB;
        for (int t = 0; t < nt; t += 2) {
            const bool last = (t == nt - 2);
            const char* a1 = cA + (size_t)(t + 1) * kstep;
            const char* a2 = last ? nA : cA + (size_t)(t + 2) * kstep; const char* b2 = last ? nB : cB + (size_t)(t + 2) * kstep;
            const char* a3 = a2 + kstep; const char* b3 = b2 + kstep;
            if (last && has_next) S.a_ready(nxt);
            if constexpr (SP2) {
            PG8_LDB(B0, 0, 0); PG8_LDB(B1, 0, 1); PG8_SCHED; PG8_LDA(At, 0, 0); PG8_STAGE(PG8_SA(1, 1), a1 + hstep, voffA);
            PG8_WAIT_V(8); PG8_WAIT_L(0); PG8_BAR; PG8_MMA(0, 0, At, B0); PG8_MMA(0, 1, At, B1); PG8_BAR; PG8_SCHED;
            PG8_LDA(At, 0, 1); PG8_STAGE(PG8_SB(0, 0), b2, voffB); PG8_STAGE(PG8_SB(0, 1), b2 + hstep, voffB); PG8_STAGE(PG8_SA(0, 0), a2, voffA);
            PG8_WAIT_V(8); PG8_WAIT_L(0); PG8_BAR; PG8_MMA(1, 0, At, B0); PG8_MMA(1, 1, At, B1); PG8_BAR; PG8_SCHED;
            PG8_LDB(B0, 1, 0); PG8_LDB(B1, 1, 1); PG8_SCHED; PG8_LDA(At, 1, 0); PG8_STAGE(PG8_SA(0, 1), a2 + hstep, voffA);
            PG8_WAIT_V(8); PG8_WAIT_L(0); PG8_BAR; PG8_MMA(0, 0, At, B0); PG8_MMA(0, 1, At, B1); PG8_BAR; PG8_SCHED;
            PG8_LDA(At, 1, 1); PG8_STAGE(PG8_SB(1, 0), b3, voffB); PG8_STAGE(PG8_SB(1, 1), b3 + hstep, voffB); PG8_STAGE(PG8_SA(1, 0), a3, voffA);
            PG8_WAIT_V(8); PG8_WAIT_L(0); PG8_BAR; PG8_MMA(1, 0, At, B0); PG8_MMA(1, 1, At, B1); PG8_BAR; PG8_SCHED;
            } else {
            PG8_LDB(B0, 0, 0); PG8_SCHED; PG8_LDA(At, 0, 0); PG8_STAGE(PG8_SA(1, 1), a1 + hstep, voffA);
            PG8_WAIT_L(8); PG8_BAR; PG8_WAIT_L(0); PG8_MMA(0, 0, At, B0); PG8_BAR; PG8_SCHED;
            PG8_LDB(B1, 0, 1); PG8_STAGE(PG8_SB(0, 0), b2, voffB);
            PG8_BAR; PG8_WAIT_L(0); PG8_MMA(0, 1, At, B1); PG8_BAR;
            PG8_LDA(At, 0, 1); PG8_STAGE(PG8_SA(0, 0), a2, voffA);
            PG8_BAR; PG8_WAIT_L(0); PG8_MMA(1, 0, At, B0); PG8_BAR; PG8_SCHED;
            PG8_STAGE(PG8_SB(0, 1), b2 + hstep, voffB);
            PG8_WAIT_V(6); PG8_BAR; PG8_MMA(1, 1, At, B1); PG8_BAR;
            PG8_LDB(B0, 1, 0); PG8_SCHED; PG8_LDA(At, 1, 0); PG8_STAGE(PG8_SA(0, 1), a2 + hstep, voffA);
            PG8_WAIT_L(8); PG8_BAR; PG8_WAIT_L(0); PG8_MMA(0, 0, At, B0); PG8_BAR; PG8_SCHED;
            PG8_LDB(B1, 1, 1); PG8_STAGE(PG8_SB(1, 0), b3, voffB);
            PG8_BAR; PG8_WAIT_L(0); PG8_MMA(0, 1, At, B1); PG8_BAR;
            PG8_LDA(At, 1, 1); PG8_STAGE(PG8_SA(1, 0), a3, voffA);
            PG8_BAR; PG8_WAIT_L(0); PG8_MMA(1, 0, At, B0); PG8_BAR; PG8_SCHED;
            PG8_STAGE(PG8_SB(1, 1), b3 + hstep, voffB);
            PG8_WAIT_V(6); PG8_BAR; PG8_MMA(1, 1, At, B1); PG8_BAR;
            }
        }
        if constexpr (ALIGN_EPI) { if (wr == 0) PG8_BAR; }
        if constexpr (!Epi::AFTER_DRAIN) { E(acc, cur, wr, wc, fr, fq); S.done(cur); }
        if (!has_next) break;
#pragma unroll
        for (int a = 0; a < 2; ++a)
#pragma unroll
            for (int b = 0; b < 2; ++b)
#pragma unroll
                for (int m = 0; m < 4; ++m)
#pragma unroll
                    for (int n = 0; n < 2; ++n) acc[a][b][m][n] = (f32x4){0.f, 0.f, 0.f, 0.f};
        cur = nxt; cA = nA; cB = nB; ++ui;
        if constexpr (ALIGN_EPI) { if (wr == 1) PG8_BAR; }
    }
    PG8_WAIT_V(0);
    if constexpr (!ALIGN_EPI) { if (wr == 0) PG8_BAR; }
    PG8_BAR;
    if constexpr (Epi::AFTER_DRAIN) { E.fused(acc, cur, wr, wc, fr, fq, lds, wid, lane); S.done(cur); }
#undef PG8_SA
#undef PG8_SB
#undef PG8_STAGE
#undef PG8_LDA
#undef PG8_LDB
#undef PG8_MMA
#undef PG8_WAIT_V
#undef PG8_WAIT_L
#undef PG8_BAR
#undef PG8_SCHED
}
}

#ifndef MK_ONE_LAUNCH
#define MK_ONE_LAUNCH 1
#endif
typedef unsigned short bf16;
typedef unsigned v4u __attribute__((ext_vector_type(4)));
typedef unsigned v2u __attribute__((ext_vector_type(2)));
typedef float f32x4 __attribute__((ext_vector_type(4)));
typedef short bf16x8 __attribute__((ext_vector_type(8)));

constexpr int NWAVES = 8, NTHR = 512;
constexpr int DM = 1024, NB = 4, SEQ = 4096, CTXL = 256;
constexpr int MLAT = NB * SEQ, MCTX = NB * CTXL, MTOT = MLAT + MCTX;
constexpr int PROJ = 5152, NPAD = 5376;
constexpr int NQL = 128, NQ = 136;
constexpr float EPS = 1e-6f;
constexpr size_t MiB = 1u << 20;
constexpr size_t WS_MODP = 1 * MiB, WS_GATE = 1 * MiB + 512 * 1024, WS_WIN = 2 * MiB, WS_WOUT = 14 * MiB, WS_HM = 18 * MiB, WS_PV = 52 * MiB,
                 WS_XBCR = 84 * MiB, WS_MIX = 148 * MiB, WS_PC = 212 * MiB, WS_DT = 216 * MiB, WS_XT = 219 * MiB, WS_CM = 18 * MiB, WS_ST = 52 * MiB, WS_END = 256 * MiB;
constexpr size_t DO_BM = 0, DO_BT = 17 * MiB, DO_AF = 34 * MiB, DO_RB = 36 * MiB, DO_DTF = 38 * MiB, DO_DTB = 40 * MiB;
constexpr int LDS_BYTES = 147456;

__device__ __forceinline__ float bf2f(unsigned short h) { return __uint_as_float((unsigned)h << 16); }
__device__ __forceinline__ float bflo(unsigned u) { return __uint_as_float(u << 16); }
__device__ __forceinline__ float bfhi(unsigned u) { return __uint_as_float(u & 0xffff0000u); }
__device__ __forceinline__ unsigned pk2(float lo, float hi) { return pg8::cvt_pk_bf16(lo, hi); }
__device__ __forceinline__ float silu_f(float x) { return x / (1.0f + __expf(-x)); }
__device__ __forceinline__ float wave_sum(float v) {
#pragma unroll
    for (int o = 1; o < 64; o <<= 1) v += __shfl_xor(v, o);
    return v;
}
#define MFMA16(a, b, c) __builtin_amdgcn_mfma_f32_16x16x32_bf16((a), (b), (c), 0, 0, 0)

struct Args {
    const float *x, *c, *ctx, *c_ctx, *norm_w, *w_ada, *b_ada, *w_in, *conv_w, *conv_b, *a_log, *dt_bias, *d_skip, *ssd_norm_w, *pool_w, *pool_scale, *w_out, *final_norm_w;
    float* out; unsigned char* ws; int ph_lo, ph_hi;
};

__device__ __forceinline__ void transpose_item(const float* W, int ldw, int n0, int k0, bf16* WT, int K, float* scr, int lane) {
#pragma unroll 8
    for (int i = 0; i < 32; ++i) { const int kk = 2 * i + (lane >> 5); scr[kk * 33 + (lane & 31)] = W[(size_t)(k0 + kk) * ldw + n0 + (lane & 31)]; }
    asm volatile("s_waitcnt lgkmcnt(0)" ::: "memory");
    const int c = lane & 7;
#pragma unroll
    for (int j = 0; j < 4; ++j) { const int n = (lane >> 3) + 8 * j; const float* s = scr + (8 * c) * 33 + n;
        v4u o; o.x = pk2(s[0 * 33], s[1 * 33]); o.y = pk2(s[2 * 33], s[3 * 33]); o.z = pk2(s[4 * 33], s[5 * 33]); o.w = pk2(s[6 * 33], s[7 * 33]);
        *(v4u*)(WT + (size_t)(n0 + n) * K + k0 + 8 * c) = o; }
    asm volatile("s_waitcnt lgkmcnt(0)" ::: "memory");
}

__device__ __forceinline__ void p0_prep(const Args& a, unsigned char* lds) {
    const int tid = threadIdx.x, lane = tid & 63, wave = tid >> 6, G = gridDim.x, bx = blockIdx.x;
    bf16* WIN = (bf16*)(a.ws + WS_WIN); bf16* WOUT = (bf16*)(a.ws + WS_WOUT); float* MODP = (float*)(a.ws + WS_MODP);
    {
        float* sv = (float*)lds;
        float* red = sv + 640;
        for (int it = bx; it < 192; it += G) {
            const int cb = it % 24, ks = it / 24, c0 = cb * 128, k0 = ks * 128;
            for (int i = tid; i < 640; i += NTHR) { const int r = i >> 7, k = i & 127; const float v = r < 4 ? a.c[r * DM + k0 + k] : a.c_ctx[k0 + k]; sv[i] = silu_f(v); }
            __syncthreads();
            const int col = tid & 127, kq = tid >> 7;
            float acc[5] = {0.f, 0.f, 0.f, 0.f, 0.f};
#pragma unroll 8
            for (int kk = 0; kk < 32; ++kk) { const int k = kq * 32 + kk; const float w = a.w_ada[(size_t)(k0 + k) * 3072 + c0 + col];
#pragma unroll
                for (int r = 0; r < 5; ++r) acc[r] += sv[r * 128 + k] * w; }
#pragma unroll
            for (int r = 0; r < 5; ++r) red[(kq * 5 + r) * 128 + col] = acc[r];
            __syncthreads();
            for (int i = tid; i < 640; i += NTHR) { const int r = i >> 7, cc = i & 127;
                MODP[(size_t)(ks * 5 + r) * 3072 + c0 + cc] = (red[(0 * 5 + r) * 128 + cc] + red[(1 * 5 + r) * 128 + cc]) + (red[(2 * 5 + r) * 128 + cc] + red[(3 * 5 + r) * 128 + cc]); }
            __syncthreads();
        }
    }
    {
        float* wl = (float*)lds;
        for (int it = bx; it < 256; it += G) {
            const int g = it >> 6, k0 = (it & 63) * 16;
#pragma unroll
            for (int j = 0; j < 8; ++j) { const int i = tid + j * NTHR, kk = i >> 8, cc = i & 255; wl[i] = a.w_in[(size_t)(k0 + kk) * PROJ + g * 256 + cc]; }
            __syncthreads();
            const int d = tid & 255, kh = tid >> 8;
            float acc[8] = {0.f, 0.f, 0.f, 0.f, 0.f, 0.f, 0.f, 0.f};
            const float* pw = a.pool_w + (size_t)g * 65536 + d;
#pragma unroll 4
            for (int cc = 0; cc < 256; ++cc) { const float p = pw[(size_t)cc * 256];
#pragma unroll
                for (int j = 0; j < 8; ++j) acc[j] += wl[(kh * 8 + j) * 256 + cc] * p; }
            v4u o; o.x = pk2(acc[0], acc[1]); o.y = pk2(acc[2], acc[3]); o.z = pk2(acc[4], acc[5]); o.w = pk2(acc[6], acc[7]);
            *(v4u*)(WIN + (size_t)(g * 256 + d) * DM + k0 + kh * 8) = o;
            __syncthreads();
        }
    }
    {
        float* scr = (float*)lds + wave * (64 * 33);
        const int gw = bx * NWAVES + wave, NGW = G * NWAVES;
        constexpr int I_IN = 16 * 129, I_OUT = 32 * 32;
        for (int it = gw; it < I_IN + I_OUT; it += NGW) {
            if (it < I_IN) { const int kb = it / 129, nb = it % 129; transpose_item(a.w_in, PROJ, 1024 + 32 * nb, 64 * kb, WIN, DM, scr, lane); }
            else { const int r = it - I_IN, kb = r >> 5, nb = r & 31; transpose_item(a.w_out, DM, 32 * nb, 64 * kb, WOUT, 2048, scr, lane); }
        }
        v4u z = {0u, 0u, 0u, 0u};
        v4u* zp = (v4u*)(WIN + (size_t)PROJ * DM);
        for (int i = bx * NTHR + tid; i < (NPAD - PROJ) * DM / 8; i += G * NTHR) zp[i] = z;
    }
    __syncthreads();
}

__device__ __forceinline__ void p1_hm(const Args& a, unsigned char* lds) {
    const int tid = threadIdx.x, lane = tid & 63, wave = tid >> 6, G = gridDim.x, bx = blockIdx.x;
    const float* MODP = (const float*)(a.ws + WS_MODP); float* GATE = (float*)(a.ws + WS_GATE); bf16* HM = (bf16*)(a.ws + WS_HM);
    float* sA = (float*)lds; float* sB = sA + 1024;
    for (int i = bx * NTHR + tid; i < 4096; i += G * NTHR) { const int bi = i >> 10, k = i & 1023; float g = a.b_ada[2048 + k];
        for (int s = 0; s < 8; ++s) g += MODP[(size_t)(s * 5 + bi) * 3072 + 2048 + k];
        GATE[i] = g; }
    for (int grp = bx; grp < MTOT / 64; grp += G) {
        const int bi = grp < 256 ? (grp >> 6) : 4;
        __syncthreads();
        for (int k = tid; k < 1024; k += NTHR) { float sh = a.b_ada[k], sc = a.b_ada[1024 + k];
            for (int s = 0; s < 8; ++s) { sh += MODP[(size_t)(s * 5 + bi) * 3072 + k]; sc += MODP[(size_t)(s * 5 + bi) * 3072 + 1024 + k]; }
            sA[k] = a.norm_w[k] * (1.0f + sc); sB[k] = sh; }
        __syncthreads();
        for (int rr = 0; rr < 8; ++rr) {
            const int row = grp * 64 + wave * 8 + rr;
            const float* src = row < MLAT ? a.x + (size_t)row * DM : a.ctx + (size_t)(row - MLAT) * DM;
            const f32x4* xr = (const f32x4*)src + lane;
            f32x4 v[4]; float s = 0.f;
#pragma unroll
            for (int j = 0; j < 4; ++j) { v[j] = xr[64 * j]; s += (v[j].x * v[j].x + v[j].y * v[j].y) + (v[j].z * v[j].z + v[j].w * v[j].w); }
            const float rstd = rsqrtf(wave_sum(s) * (1.0f / DM) + EPS);
            v2u* o8 = (v2u*)(HM + (size_t)row * DM) + lane;
#pragma unroll
            for (int j = 0; j < 4; ++j) { const int k = 4 * (lane + 64 * j); const f32x4 ga = *(const f32x4*)(sA + k), gb = *(const f32x4*)(sB + k);
                v2u o; o.x = pk2(v[j].x * rstd * ga.x + gb.x, v[j].y * rstd * ga.y + gb.y); o.y = pk2(v[j].z * rstd * ga.z + gb.z, v[j].w * rstd * ga.w + gb.w);
                o8[64 * j] = o; }
        }
    }
    __syncthreads();
}

struct SchedIn {
    pg8::StaticOrder S0; int G, c;
    __device__ void init(int G_, int c_) { S0.init(MLAT, NPAD, G_, c_); G = G_; c = c_; }
    __device__ bool next(int i, pg8::Unit& u) const {
        if (S0.next(i, u)) return true;
        const long L = (long)i * G + c - S0.nwg; if (L >= 36) return false;
        u.pm = 64 + (int)(L & 3); u.pn = 12 + (int)(L >> 2); return true;
    }
    __device__ __forceinline__ void a_ready(const pg8::Unit&) const {}
    __device__ __forceinline__ void done(const pg8::Unit&) const {}
};
__device__ __forceinline__ float softplus_f(float x) { return fmaxf(x, 0.f) + log1pf(__expf(-fabsf(x))); }
struct EpiIn {
    static constexpr bool PERM = true, AFTER_DRAIN = false;
    bf16 *PV, *MIX, *XBCR, *PC; float* DT; const float* dt_bias;
    __device__ __forceinline__ void operator()(const pg8::f32x4 (&acc)[2][2][4][2], const pg8::Unit& u, int wr, int wc, int fr, int fq) const {
        using namespace pg8;
        const int pn = u.pn;
        if (pn < 20) {
            bf16* base; int ldc, colt; int row0 = u.pm * BM + wr * 64 + fr;
            if (u.pm >= 64) { base = PC; ldc = 2048; colt = (pn - 12) * 256; row0 -= MLAT; }
            else if (pn < 4) { base = PV; ldc = 1024; colt = pn * 256; }
            else if (pn < 12) { base = MIX; ldc = 2048; colt = (pn - 4) * 256; }
            else { base = XBCR; ldc = 2048; colt = (pn - 12) * 256; }
            const int col0 = colt + wc * 32 + 8 * fq;
#pragma unroll
            for (int ai = 0; ai < 2; ++ai)
#pragma unroll
                for (int m = 0; m < 4; ++m) { bf16* rowp = base + (size_t)(row0 + ai * HALF + m * 16) * ldc + col0;
#pragma unroll
                    for (int bj = 0; bj < 2; ++bj) { const pg8::f32x4 v0 = acc[ai][bj][m][0], v1 = acc[ai][bj][m][1];
                        pg8::u32x4 w; w.x = cvt_pk_bf16(v0[0], v0[1]); w.y = cvt_pk_bf16(v0[2], v0[3]); w.z = cvt_pk_bf16(v1[0], v1[1]); w.w = cvt_pk_bf16(v1[2], v1[3]);
                        *(pg8::u32x4*)(rowp + bj * HALF) = w; } }
        } else if (wc == 0) {
            const int row0 = u.pm * BM + wr * 64 + fr, col0 = 8 * fq;
            const pg8::f32x4 b0 = *(const pg8::f32x4*)(dt_bias + col0), b1 = *(const pg8::f32x4*)(dt_bias + col0 + 4);
#pragma unroll
            for (int ai = 0; ai < 2; ++ai)
#pragma unroll
                for (int m = 0; m < 4; ++m) { float* rowp = DT + (size_t)(row0 + ai * HALF + m * 16) * 32 + col0;
                    const pg8::f32x4 v0 = acc[ai][0][m][0] + b0, v1 = acc[ai][0][m][1] + b1;
                    pg8::f32x4 o0, o1;
#pragma unroll
                    for (int j = 0; j < 4; ++j) { o0[j] = softplus_f(v0[j]); o1[j] = softplus_f(v1[j]); }
                    *(pg8::f32x4*)rowp = o0; *(pg8::f32x4*)(rowp + 4) = o1; }
        }
    }
};
struct EpiOut {
    static constexpr bool PERM = false, AFTER_DRAIN = false;
    const float* x; const float* gate; float* out;
    __device__ __forceinline__ void operator()(const pg8::f32x4 (&acc)[2][2][4][2], const pg8::Unit& u, int wr, int wc, int fr, int fq) const {
        using namespace pg8;
        const int row0 = u.pm * BM + wr * 64 + fr, col0 = u.pn * BM + wc * 32 + 4 * fq;
        const float* gb = gate + (size_t)(u.pm >> 4) * DM;
#pragma unroll
        for (int ai = 0; ai < 2; ++ai)
#pragma unroll
            for (int m = 0; m < 4; ++m) { const size_t off = (size_t)(row0 + ai * HALF + m * 16) * DM + col0;
#pragma unroll
                for (int bj = 0; bj < 2; ++bj)
#pragma unroll
                    for (int n = 0; n < 2; ++n) { const int cc = bj * HALF + n * 16; const pg8::f32x4 xv = *(const pg8::f32x4*)(x + off + cc), gv = *(const pg8::f32x4*)(gb + col0 + cc);
                        *(pg8::f32x4*)(out + off + cc) = xv + gv * acc[ai][bj][m][n]; } }
    }
};

__device__ __forceinline__ void p3_conv_unit(const Args& a, unsigned char* lds, int u) {
    const int tid = threadIdx.x;
    const int q = u >> 4, slab = u & 15, col0 = slab * 128;
    int seq_len, l0, rowbase; const bf16* src;
    if (q < NQL) { seq_len = SEQ; l0 = (q & 31) * 128; rowbase = (q >> 5) * SEQ; src = (const bf16*)(a.ws + WS_XBCR); }
    else { const int qq = q - NQL; seq_len = CTXL; l0 = (qq & 1) * 128; rowbase = (qq >> 1) * CTXL; src = (const bf16*)(a.ws + WS_PC); }
    bf16* R = (bf16*)lds;
    bf16* O = (bf16*)(lds + 33536);
    unsigned char* OT = lds + 33536 + 32768;
    for (int i = tid; i < 131 * 16; i += NTHR) { const int row = i >> 4, ck = i & 15, t = l0 - 2 + row;
        v4u v = {0u, 0u, 0u, 0u};
        if (t >= 0 && t < seq_len) v = *(const v4u*)(src + (size_t)(rowbase + t) * 2048 + col0 + ck * 8);
        *(v4u*)(R + row * 128 + ck * 8) = v; }
    __syncthreads();
    {
        const int ch = tid & 127, lq = tid >> 7;
        const float w0 = a.conv_w[0 * 2048 + col0 + ch], w1 = a.conv_w[1 * 2048 + col0 + ch], w2 = a.conv_w[2 * 2048 + col0 + ch], w3 = a.conv_w[3 * 2048 + col0 + ch], bs = a.conv_b[col0 + ch];
        const int lb = lq * 32;
        float r0 = bf2f(R[(lb + 0) * 128 + ch]), r1 = bf2f(R[(lb + 1) * 128 + ch]), r2 = bf2f(R[(lb + 2) * 128 + ch]);
#pragma unroll 4
        for (int l = lb; l < lb + 32; l += 2) {
            const float r3 = bf2f(R[(l + 3) * 128 + ch]), r4 = bf2f(R[(l + 4) * 128 + ch]);
            const float y0 = silu_f(bs + w0 * r0 + w1 * r1 + w2 * r2 + w3 * r3);
            const float y1 = silu_f(bs + w0 * r1 + w1 * r2 + w2 * r3 + w3 * r4);
            const unsigned pk = pk2(y0, y1);
            O[l * 128 + ch] = (bf16)(pk & 0xffffu); O[(l + 1) * 128 + ch] = (bf16)(pk >> 16);
            *(unsigned*)(OT + ch * 260 + l * 2) = pk;
            r0 = r2; r1 = r3; r2 = r4;
        }
    }
    __syncthreads();
    if (slab >= 8) {
        const int g = slab & 3;
        bf16* dst = (slab < 12 ? (bf16*)((unsigned char*)a.out + DO_BM) : (bf16*)(a.ws + WS_CM)) + (size_t)(q * 4 + g) * 16384;
#pragma unroll
        for (int j = 0; j < 4; ++j) { const int i = tid + j * NTHR; *(v4u*)(dst + i * 8) = *(const v4u*)(O + i * 8); }
    }
    if (slab < 12) {
        unsigned* dst = slab < 8 ? (unsigned*)((bf16*)(a.ws + WS_XT) + (size_t)(q * 16 + 2 * slab) * 8192) : (unsigned*)((bf16*)((unsigned char*)a.out + DO_BT) + (size_t)(q * 4 + (slab - 8)) * 16384);
#pragma unroll
        for (int j = 0; j < 16; ++j) { const int i = tid + j * NTHR, row = i >> 6, dw = i & 63; dst[i] = *(const unsigned*)(OT + row * 260 + dw * 4); }
    }
    __syncthreads();
}

__device__ __forceinline__ void p3_pool_unit(const Args& a, unsigned char* lds, int u) {
    const int tid = threadIdx.x;
    const int b = u >> 8, r = (u >> 2) & 63, g = u & 3, hw = 1 << g;
    const int r_lo = max(r - hw, 0), r_hi = min(r + hw, 64);
    const bf16* PV = (const bf16*)(a.ws + WS_PV); bf16* MIX = (bf16*)(a.ws + WS_MIX);
    float* CM = (float*)lds;
    const int co = tid & 31, c4 = (tid >> 5) * 4;
    float acc[4][8];
#pragma unroll
    for (int ci = 0; ci < 4; ++ci)
#pragma unroll
        for (int e = 0; e < 8; ++e) acc[ci][e] = 0.f;
    for (int rr = r_lo; rr < r_hi; ++rr) {
#pragma unroll
        for (int ci = 0; ci < 4; ++ci) { const v4u v = *(const v4u*)(PV + (size_t)(b * SEQ + rr * 64 + c4 + ci) * 1024 + g * 256 + co * 8);
            acc[ci][0] += bflo(v.x); acc[ci][1] += bfhi(v.x); acc[ci][2] += bflo(v.y); acc[ci][3] += bfhi(v.y);
            acc[ci][4] += bflo(v.z); acc[ci][5] += bfhi(v.z); acc[ci][6] += bflo(v.w); acc[ci][7] += bfhi(v.w); }
    }
    const float inv1 = 1.0f / (float)(r_hi - r_lo);
#pragma unroll
    for (int ci = 0; ci < 4; ++ci) { f32x4 o0 = {acc[ci][0] * inv1, acc[ci][1] * inv1, acc[ci][2] * inv1, acc[ci][3] * inv1}, o1 = {acc[ci][4] * inv1, acc[ci][5] * inv1, acc[ci][6] * inv1, acc[ci][7] * inv1};
        *(f32x4*)(CM + (c4 + ci) * 256 + co * 8) = o0; *(f32x4*)(CM + (c4 + ci) * 256 + co * 8 + 4) = o1; }
    __syncthreads();
    {
        f32x4 s0 = {0.f, 0.f, 0.f, 0.f}, s1 = {0.f, 0.f, 0.f, 0.f};
        int lo = max(c4 - hw, 0), hi = min(c4 + hw, 64);
        for (int cc = lo; cc < hi; ++cc) { s0 += *(const f32x4*)(CM + cc * 256 + co * 8); s1 += *(const f32x4*)(CM + cc * 256 + co * 8 + 4); }
        const f32x4 ps0 = *(const f32x4*)(a.pool_scale + g * 256 + co * 8), ps1 = *(const f32x4*)(a.pool_scale + g * 256 + co * 8 + 4);
#pragma unroll
        for (int ci = 0; ci < 4; ++ci) {
            const int c = c4 + ci;
            if (ci > 0) { const int nlo = max(c - hw, 0), nhi = min(c + hw, 64);
                if (nhi > hi) { s0 += *(const f32x4*)(CM + hi * 256 + co * 8); s1 += *(const f32x4*)(CM + hi * 256 + co * 8 + 4); }
                if (nlo > lo) { s0 -= *(const f32x4*)(CM + lo * 256 + co * 8); s1 -= *(const f32x4*)(CM + lo * 256 + co * 8 + 4); }
                lo = nlo; hi = nhi; }
            const float inv2 = 1.0f / (float)(hi - lo);
            const size_t tok = (size_t)(b * SEQ + r * 64 + c);
            const v4u vv = *(const v4u*)(PV + tok * 1024 + g * 256 + co * 8);
            v4u* zp = (v4u*)(MIX + tok * 2048 + g * 256 + co * 8);
            const v4u zz = *zp;
            float m[8] = {s0[0] * inv2, s0[1] * inv2, s0[2] * inv2, s0[3] * inv2, s1[0] * inv2, s1[1] * inv2, s1[2] * inv2, s1[3] * inv2};
            float v[8] = {bflo(vv.x), bfhi(vv.x), bflo(vv.y), bfhi(vv.y), bflo(vv.z), bfhi(vv.z), bflo(vv.w), bfhi(vv.w)};
            float z[8] = {bflo(zz.x), bfhi(zz.x), bflo(zz.y), bfhi(zz.y), bflo(zz.z), bfhi(zz.z), bflo(zz.w), bfhi(zz.w)};
            float ps[8] = {ps0[0], ps0[1], ps0[2], ps0[3], ps1[0], ps1[1], ps1[2], ps1[3]};
            float y[8];
#pragma unroll
            for (int e = 0; e < 8; ++e) y[e] = (m[e] - v[e]) * ps[e] * silu_f(z[e]);
            v4u o; o.x = pk2(y[0], y[1]); o.y = pk2(y[2], y[3]); o.z = pk2(y[4], y[5]); o.w = pk2(y[6], y[7]);
            *zp = o;
        }
    }
    __syncthreads();
}

__device__ __forceinline__ void p3_cumsum_item(const Args& a, int it, int lane) {
    const int q = it >> 4, h = it & 15;
    const float* DT = (const float*)(a.ws + WS_DT);
    const float af = -__expf(a.a_log[h]), ab = -__expf(a.a_log[16 + h]);
    const int l0 = 2 * lane;
    const float dtf0 = DT[(size_t)(q * 128 + l0) * 32 + h], dtf1 = DT[(size_t)(q * 128 + l0 + 1) * 32 + h];
    const float dtb0 = DT[(size_t)(q * 128 + l0) * 32 + 16 + h], dtb1 = DT[(size_t)(q * 128 + l0 + 1) * 32 + 16 + h];
    const float v0 = dtf0 * af, v1 = dtf1 * af, w0 = dtb0 * ab, w1 = dtb1 * ab;
    float inc = v0 + v1, sinc = w0 + w1;
#pragma unroll
    for (int o = 1; o < 64; o <<= 1) { const float t = __shfl_up(inc, o); if (lane >= o) inc += t; const float s = __shfl_down(sinc, o); if (lane + o < 64) sinc += s; }
    const size_t base = (size_t)(q * 16 + h) * 128 + l0;
    float2 o;
    o.x = inc - v1; o.y = inc; *(float2*)((float*)((unsigned char*)a.out + DO_AF) + base) = o;
    o.x = sinc; o.y = sinc - w0; *(float2*)((float*)((unsigned char*)a.out + DO_RB) + base) = o;
    o.x = dtf0; o.y = dtf1; *(float2*)((float*)((unsigned char*)a.out + DO_DTF) + base) = o;
    o.x = dtb0; o.y = dtb1; *(float2*)((float*)((unsigned char*)a.out + DO_DTB) + base) = o;
}

__device__ __forceinline__ void p3_all(const Args& a, unsigned char* lds) {
    const int G = gridDim.x, bx = blockIdx.x, tid = threadIdx.x;
    constexpr int NCONV = NQ * 16, NPOOL = 1024;
    for (int it = bx; it < NCONV + NPOOL; it += G) { if (it < NCONV) p3_conv_unit(a, lds, it); else p3_pool_unit(a, lds, it - NCONV); }
    for (int it = bx * NWAVES + (tid >> 6); it < NQ * 16; it += G * NWAVES) p3_cumsum_item(a, it, tid & 63);
}

__device__ __forceinline__ void p4_states(const Args& a, unsigned char* lds) {
    const int tid = threadIdx.x, lane = tid & 63, wave = tid >> 6, G = gridDim.x, bx = blockIdx.x, r = lane & 15, qd = lane >> 4;
    const bf16* BT = (const bf16*)((unsigned char*)a.out + DO_BT); const bf16* XT = (const bf16*)(a.ws + WS_XT); bf16* ST = (bf16*)(a.ws + WS_ST);
    const float* AF = (const float*)((unsigned char*)a.out + DO_AF); const float* RB = (const float*)((unsigned char*)a.out + DO_RB);
    const float* DTF = (const float*)((unsigned char*)a.out + DO_DTF); const float* DTB = (const float*)((unsigned char*)a.out + DO_DTB);
    for (int u = bx; u < NQ * 4; u += G) {
        const int q = u >> 2, g = u & 3;
        __syncthreads();
        { const bf16* srcb = BT + (size_t)u * 16384;
#pragma unroll
          for (int j = 0; j < 4; ++j) { const int i = tid + j * NTHR, row = i >> 4, ck = i & 15; *(v4u*)(lds + row * 272 + ck * 16) = *(const v4u*)(srcb + row * 128 + ck * 8); } }
        __syncthreads();
        const int h = g * 4 + (wave >> 1), dir = wave & 1;
        const size_t vb = (size_t)(q * 16 + h) * 128;
        const float* cum = dir ? RB + vb : AF + vb; const float* dtv = dir ? DTB + vb : DTF + vb;
        const float cend = dir ? cum[0] : cum[127];
        f32x4 acc[8][4];
#pragma unroll
        for (int nt = 0; nt < 8; ++nt)
#pragma unroll
            for (int pt = 0; pt < 4; ++pt) acc[nt][pt] = (f32x4){0.f, 0.f, 0.f, 0.f};
        const bf16* xb = XT + (size_t)(q * 16 + h) * 8192;
#pragma unroll 1
        for (int ks = 0; ks < 4; ++ks) {
            const int lk = ks * 32 + qd * 8;
            float wg[8];
            { const f32x4 c0 = *(const f32x4*)(cum + lk), c1 = *(const f32x4*)(cum + lk + 4), d0 = *(const f32x4*)(dtv + lk), d1 = *(const f32x4*)(dtv + lk + 4);
#pragma unroll
              for (int j = 0; j < 4; ++j) { wg[j] = __expf(cend - c0[j]) * d0[j]; wg[4 + j] = __expf(cend - c1[j]) * d1[j]; } }
            bf16x8 xf[4];
#pragma unroll
            for (int pt = 0; pt < 4; ++pt) { const v4u v = *(const v4u*)(xb + (pt * 16 + r) * 128 + lk);
                v4u o; o.x = pk2(bflo(v.x) * wg[0], bfhi(v.x) * wg[1]); o.y = pk2(bflo(v.y) * wg[2], bfhi(v.y) * wg[3]); o.z = pk2(bflo(v.z) * wg[4], bfhi(v.z) * wg[5]); o.w = pk2(bflo(v.w) * wg[6], bfhi(v.w) * wg[7]);
                xf[pt] = __builtin_bit_cast(bf16x8, o); }
#pragma unroll
            for (int nt = 0; nt < 8; ++nt) { const bf16x8 bfrag = *(const bf16x8*)(lds + (nt * 16 + r) * 272 + lk * 2);
#pragma unroll
                for (int pt = 0; pt < 4; ++pt) acc[nt][pt] = MFMA16(bfrag, xf[pt], acc[nt][pt]); }
        }
        bf16* dst = ST + ((size_t)(q * 16 + h) * 2 + dir) * 8192;
#pragma unroll
        for (int nt = 0; nt < 8; ++nt)
#pragma unroll
            for (int pt = 0; pt < 4; ++pt) { v2u o; o.x = pk2(acc[nt][pt][0], acc[nt][pt][1]); o.y = pk2(acc[nt][pt][2], acc[nt][pt][3]);
                *(v2u*)(dst + (pt * 16 + r) * 128 + nt * 16 + qd * 4) = o; }
    }
    __syncthreads();
}

__device__ __forceinline__ void p5_scan(const Args& a) {
    const int G = gridDim.x;
    bf16* ST = (bf16*)(a.ws + WS_ST);
    const float* AF = (const float*)((unsigned char*)a.out + DO_AF); const float* RB = (const float*)((unsigned char*)a.out + DO_RB);
    for (int e = blockIdx.x * NTHR + threadIdx.x; e < NB * 16 * 2 * 64 * 16; e += G * NTHR) {
        const int n8 = e & 15, p = (e >> 4) & 63, dir = (e >> 10) & 1, h = (e >> 11) & 15, b = e >> 15;
        float hs[8] = {0.f, 0.f, 0.f, 0.f, 0.f, 0.f, 0.f, 0.f};
        const size_t eo = (size_t)dir * 8192 + p * 128 + n8 * 8;
        for (int s = 0; s < 2; ++s) {
            const int q = NQL + b * 2 + (dir ? 1 - s : s);
            const float cd = __expf(dir ? RB[(size_t)(q * 16 + h) * 128] : AF[(size_t)(q * 16 + h) * 128 + 127]);
            const v4u v = *(const v4u*)(ST + (size_t)(q * 16 + h) * 16384 + eo);
            hs[0] = hs[0] * cd + bflo(v.x); hs[1] = hs[1] * cd + bfhi(v.x); hs[2] = hs[2] * cd + bflo(v.y); hs[3] = hs[3] * cd + bfhi(v.y);
            hs[4] = hs[4] * cd + bflo(v.z); hs[5] = hs[5] * cd + bfhi(v.z); hs[6] = hs[6] * cd + bflo(v.w); hs[7] = hs[7] * cd + bfhi(v.w);
        }
#pragma unroll 4
        for (int s = 0; s < 32; ++s) {
            const int q = b * 32 + (dir ? 31 - s : s);
            const float cd = __expf(dir ? RB[(size_t)(q * 16 + h) * 128] : AF[(size_t)(q * 16 + h) * 128 + 127]);
            v4u* ptr = (v4u*)(ST + (size_t)(q * 16 + h) * 16384 + eo);
            const v4u v = *ptr;
            v4u o; o.x = pk2(hs[0], hs[1]); o.y = pk2(hs[2], hs[3]); o.z = pk2(hs[4], hs[5]); o.w = pk2(hs[6], hs[7]);
            *ptr = o;
            hs[0] = hs[0] * cd + bflo(v.x); hs[1] = hs[1] * cd + bfhi(v.x); hs[2] = hs[2] * cd + bflo(v.y); hs[3] = hs[3] * cd + bfhi(v.y);
            hs[4] = hs[4] * cd + bflo(v.z); hs[5] = hs[5] * cd + bfhi(v.z); hs[6] = hs[6] * cd + bflo(v.w); hs[7] = hs[7] * cd + bfhi(v.w);
        }
    }
}

constexpr int P6_CM = 0, P6_BM = 34816, P6_XT = 69632, P6_HF = P6_XT + 17408, P6_HB = P6_HF + 17408, P6_VEC = P6_HB + 17408;
__device__ __forceinline__ void p6_out(const Args& a, unsigned char* lds) {
    const int tid = threadIdx.x, lane = tid & 63, wave = tid >> 6, G = gridDim.x, bx = blockIdx.x, r = lane & 15, qd = lane >> 4;
    const bf16* BMg = (const bf16*)((unsigned char*)a.out + DO_BM); const bf16* CMg = (const bf16*)(a.ws + WS_CM);
    const bf16* XT = (const bf16*)(a.ws + WS_XT); const bf16* ST = (const bf16*)(a.ws + WS_ST); bf16* MIX = (bf16*)(a.ws + WS_MIX);
    const float* AF = (const float*)((unsigned char*)a.out + DO_AF); const float* RB = (const float*)((unsigned char*)a.out + DO_RB);
    const float* DTF = (const float*)((unsigned char*)a.out + DO_DTF); const float* DTB = (const float*)((unsigned char*)a.out + DO_DTB);
    float* vec = (float*)(lds + P6_VEC);
    const int lrow = wave * 16 + r;
    for (int u = bx; u < NQL * 4; u += G) {
        const int q = u >> 2, g = u & 3;
        __syncthreads();
        { const bf16* sc = CMg + (size_t)u * 16384; const bf16* sb = BMg + (size_t)u * 16384;
#pragma unroll
          for (int j = 0; j < 4; ++j) { const int i = tid + j * NTHR, row = i >> 4, ck = i & 15;
              *(v4u*)(lds + P6_CM + row * 272 + ck * 16) = *(const v4u*)(sc + row * 128 + ck * 8);
              *(v4u*)(lds + P6_BM + row * 272 + ck * 16) = *(const v4u*)(sb + row * 128 + ck * 8); } }
        __syncthreads();
        f32x4 cb[8];
#pragma unroll
        for (int st = 0; st < 8; ++st) cb[st] = (f32x4){0.f, 0.f, 0.f, 0.f};
#pragma unroll 1
        for (int ks = 0; ks < 4; ++ks) { const bf16x8 cfr = *(const bf16x8*)(lds + P6_CM + lrow * 272 + (ks * 32 + qd * 8) * 2);
#pragma unroll
            for (int st = 0; st < 8; ++st) { const bf16x8 bfr = *(const bf16x8*)(lds + P6_BM + (st * 16 + r) * 272 + (ks * 32 + qd * 8) * 2); cb[st] = MFMA16(bfr, cfr, cb[st]); } }
        f32x4 yacc[4][4];
        const size_t tok = (size_t)q * 128 + lrow;
#pragma unroll
        for (int hl = 0; hl < 4; ++hl) {
            const int h = g * 4 + hl;
            __syncthreads();
            { const bf16* sx = XT + (size_t)(q * 16 + h) * 8192; const bf16* sf = ST + (size_t)(q * 16 + h) * 16384; const bf16* sbk = sf + 8192;
#pragma unroll
              for (int j = 0; j < 2; ++j) { const int i = tid + j * NTHR, row = i >> 4, ck = i & 15;
                  *(v4u*)(lds + P6_XT + row * 272 + ck * 16) = *(const v4u*)(sx + row * 128 + ck * 8);
                  *(v4u*)(lds + P6_HF + row * 272 + ck * 16) = *(const v4u*)(sf + row * 128 + ck * 8);
                  *(v4u*)(lds + P6_HB + row * 272 + ck * 16) = *(const v4u*)(sbk + row * 128 + ck * 8); }
              const size_t vb = (size_t)(q * 16 + h) * 128;
              { const int which = tid >> 7, l = tid & 127; const float* s = which == 0 ? AF : which == 1 ? RB : which == 2 ? DTF : DTB; vec[which * 128 + l] = s[vb + l]; } }
            __syncthreads();
            const float afl = vec[lrow], rbl = vec[128 + lrow];
#pragma unroll
            for (int st = 0; st < 8; ++st) {
                const int s0 = st * 16 + qd * 4;
                const f32x4 afs = *(const f32x4*)(vec + s0), rbs = *(const f32x4*)(vec + 128 + s0), dfs = *(const f32x4*)(vec + 256 + s0), dbs = *(const f32x4*)(vec + 384 + s0);
                float m[4];
#pragma unroll
                for (int jj = 0; jj < 4; ++jj) { const int s = s0 + jj;
                    float t = 0.f;
                    if (s <= lrow) t += __expf(afl - afs[jj]) * dfs[jj];
                    if (s >= lrow) t += __expf(rbl - rbs[jj]) * dbs[jj];
                    m[jj] = t * cb[st][jj]; }
                v2u o; o.x = pk2(m[0], m[1]); o.y = pk2(m[2], m[3]);
                *(v2u*)(lds + P6_BM + lrow * 272 + s0 * 2) = o;
            }
            asm volatile("s_waitcnt lgkmcnt(0)" ::: "memory");
            const float ef = __expf(afl), eb = __expf(rbl), dsk = a.d_skip[h];
#pragma unroll
            for (int pt = 0; pt < 4; ++pt)
#pragma unroll
                for (int jj = 0; jj < 4; ++jj) { const int p = pt * 16 + qd * 4 + jj; yacc[hl][pt][jj] = dsk * bf2f(*(const bf16*)(lds + P6_XT + p * 272 + lrow * 2)); }
#pragma unroll 1
            for (int ks = 0; ks < 4; ++ks) {
                const int ko = (ks * 32 + qd * 8) * 2;
                const v4u cr = *(const v4u*)(lds + P6_CM + lrow * 272 + ko);
                v4u t;
                t.x = pk2(bflo(cr.x) * ef, bfhi(cr.x) * ef); t.y = pk2(bflo(cr.y) * ef, bfhi(cr.y) * ef); t.z = pk2(bflo(cr.z) * ef, bfhi(cr.z) * ef); t.w = pk2(bflo(cr.w) * ef, bfhi(cr.w) * ef);
                const bf16x8 cff = __builtin_bit_cast(bf16x8, t);
                t.x = pk2(bflo(cr.x) * eb, bfhi(cr.x) * eb); t.y = pk2(bflo(cr.y) * eb, bfhi(cr.y) * eb); t.z = pk2(bflo(cr.z) * eb, bfhi(cr.z) * eb); t.w = pk2(bflo(cr.w) * eb, bfhi(cr.w) * eb);
                const bf16x8 cfb = __builtin_bit_cast(bf16x8, t);
                const bf16x8 mf = *(const bf16x8*)(lds + P6_BM + lrow * 272 + ko);
#pragma unroll
                for (int pt = 0; pt < 4; ++pt) yacc[hl][pt] = MFMA16(*(const bf16x8*)(lds + P6_XT + (pt * 16 + r) * 272 + ko), mf, yacc[hl][pt]);
#pragma unroll
                for (int pt = 0; pt < 4; ++pt) yacc[hl][pt] = MFMA16(*(const bf16x8*)(lds + P6_HF + (pt * 16 + r) * 272 + ko), cff, yacc[hl][pt]);
#pragma unroll
                for (int pt = 0; pt < 4; ++pt) yacc[hl][pt] = MFMA16(*(const bf16x8*)(lds + P6_HB + (pt * 16 + r) * 272 + ko), cfb, yacc[hl][pt]);
            }
        }
        float ss = 0.f;
        bf16* zrow = MIX + tok * 2048 + 1024 + g * 256;
#pragma unroll
        for (int hl = 0; hl < 4; ++hl)
#pragma unroll
            for (int pt = 0; pt < 4; ++pt) { const v2u zz = *(const v2u*)(zrow + hl * 64 + pt * 16 + qd * 4);
                const float z0 = bflo(zz.x), z1 = bfhi(zz.x), z2 = bflo(zz.y), z3 = bfhi(zz.y);
                f32x4 gv = yacc[hl][pt]; gv[0] *= silu_f(z0); gv[1] *= silu_f(z1); gv[2] *= silu_f(z2); gv[3] *= silu_f(z3);
                ss += (gv[0] * gv[0] + gv[1] * gv[1]) + (gv[2] * gv[2] + gv[3] * gv[3]); yacc[hl][pt] = gv; }
        ss += __shfl_xor(ss, 16); ss += __shfl_xor(ss, 32);
        const float rstd = rsqrtf(ss * (1.0f / 256.0f) + EPS);
        const float* nw = a.ssd_norm_w + g * 256;
#pragma unroll
        for (int hl = 0; hl < 4; ++hl)
#pragma unroll
            for (int pt = 0; pt < 4; ++pt) { const int cix = hl * 64 + pt * 16 + qd * 4; const f32x4 w = *(const f32x4*)(nw + cix); const f32x4 gv = yacc[hl][pt];
                v2u o; o.x = pk2(gv[0] * rstd * w[0], gv[1] * rstd * w[1]); o.y = pk2(gv[2] * rstd * w[2], gv[3] * rstd * w[3]);
                *(v2u*)(zrow + cix) = o; }
    }
    __syncthreads();
}

__device__ __forceinline__ void p8_final(const Args& a) {
    const int tid = threadIdx.x, lane = tid & 63, wave = tid >> 6, G = gridDim.x;
    for (int row = blockIdx.x * NWAVES + wave; row < MLAT; row += G * NWAVES) {
        f32x4* xr = (f32x4*)(a.out + (size_t)row * DM) + lane;
        f32x4 v[4]; float s = 0.f;
#pragma unroll
        for (int j = 0; j < 4; ++j) { v[j] = xr[64 * j]; s += (v[j].x * v[j].x + v[j].y * v[j].y) + (v[j].z * v[j].z + v[j].w * v[j].w); }
        const float rstd = rsqrtf(wave_sum(s) * (1.0f / DM) + EPS);
#pragma unroll
        for (int j = 0; j < 4; ++j) { const f32x4 w = *((const f32x4*)a.final_norm_w + lane + 64 * j); xr[64 * j] = v[j] * rstd * w; }
    }
}

__global__ void __launch_bounds__(NTHR, 2) fwd_kernel(Args args) {
    extern __shared__ __attribute__((aligned(16))) unsigned char lds[];
    cg::grid_group grid = cg::this_grid();
    const int lo = args.ph_lo, hi = args.ph_hi;
#define IN(k) (lo <= (k) && (k) < hi)
#define SEAM(k) do { if (IN(k) && IN((k) + 1)) grid.sync(); } while (0)

#ifndef SKIP_P0
    if (IN(0)) p0_prep(args, lds);
#endif

    SEAM(0);

#ifndef SKIP_P1
    if (IN(1)) p1_hm(args, lds);
#endif

    SEAM(1);
#ifndef SKIP_P2
    if (IN(2)) {
        pg8::Gemm g{(const pg8::bf16_t*)(args.ws + WS_HM), (const pg8::bf16_t*)(args.ws + WS_WIN), MTOT, NPAD, DM};
        SchedIn S; S.init((int)gridDim.x, (int)blockIdx.x);
        EpiIn E{(bf16*)(args.ws + WS_PV), (bf16*)(args.ws + WS_MIX), (bf16*)(args.ws + WS_XBCR), (bf16*)(args.ws + WS_PC), (float*)(args.ws + WS_DT), args.dt_bias};
        pg8::gemm_phase<EpiIn, SchedIn, true, true>((PG8_LAS unsigned char*)lds, g, S, E);
    }
#endif
    SEAM(2);

#ifndef SKIP_P3
    if (IN(3)) p3_all(args, lds);
#endif

    SEAM(3);

#ifndef SKIP_P4
    if (IN(4)) p4_states(args, lds);
#endif

    SEAM(4);

#ifndef SKIP_P5
    if (IN(5)) p5_scan(args);
#endif

    SEAM(5);

#ifndef SKIP_P6
    if (IN(6)) p6_out(args, lds);
#endif

    SEAM(6);
#ifndef SKIP_P7
    if (IN(7)) {
        pg8::Gemm g{(const pg8::bf16_t*)(args.ws + WS_MIX), (const pg8::bf16_t*)(args.ws + WS_WOUT), MLAT, DM, 2048};
        pg8::StaticOrder S; S.init(MLAT, DM, (int)gridDim.x, (int)blockIdx.x);
        EpiOut E{args.x, (const float*)(args.ws + WS_GATE), args.out};
        pg8::gemm_phase<EpiOut, pg8::StaticOrder, true, true>((PG8_LAS unsigned char*)lds, g, S, E);
    }
#endif
    SEAM(7);

#ifndef SKIP_P8
    if (IN(8)) p8_final(args);
#endif

#undef IN
#undef SEAM
}

extern "C" void kernel_launch(void* const* d_in, const int* in_sizes, int n_in, void* d_out, int out_size, void* d_ws, size_t ws_size, hipStream_t stream) {
    static int grid = 0;
    if (grid == 0) {
        if (n_in != 18 || out_size != MLAT * DM || ws_size < WS_END) { fprintf(stderr, "kernel_launch: unexpected shapes (n_in %d out %d ws %zu)\n", n_in, out_size, ws_size); grid = -1; return; }
        int dev = 0, cus = 0, per_cu = 0;
        hipGetDevice(&dev); hipDeviceGetAttribute(&cus, hipDeviceAttributeMultiprocessorCount, dev);
        if (hipFuncSetAttribute((const void*)fwd_kernel, hipFuncAttributeMaxDynamicSharedMemorySize, LDS_BYTES) != hipSuccess) { fprintf(stderr, "kernel_launch: hipFuncSetAttribute failed\n"); grid = -1; return; }
        if (hipOccupancyMaxActiveBlocksPerMultiprocessor(&per_cu, (const void*)fwd_kernel, NTHR, LDS_BYTES) != hipSuccess || per_cu < 1) { fprintf(stderr, "kernel_launch: occupancy query failed (%d)\n", per_cu); (void)hipGetLastError(); per_cu = 1; }
        grid = cus * (per_cu > 1 ? 1 : per_cu);
    }
    if (grid < 0) return;
    Args a{};
    const float** ap = (const float**)&a;
    for (int i = 0; i < 18; ++i) ap[i] = (const float*)d_in[i];
    a.out = (float*)d_out; a.ws = (unsigned char*)d_ws;
#if MK_ONE_LAUNCH
    a.ph_lo = 0; a.ph_hi = 9;
    void* kargs[] = {&a};
    hipError_t e = hipLaunchCooperativeKernel((const void*)fwd_kernel, dim3(grid), dim3(NTHR), kargs, LDS_BYTES, stream);
    if (e != hipSuccess) fprintf(stderr, "cooperative launch failed: %s (grid %d)\n", hipGetErrorString(e), grid);
#else
    for (int p = 0; p < 9; ++p) { a.ph_lo = p; a.ph_hi = p + 1; hipLaunchKernelGGL(fwd_kernel, dim3(grid), dim3(NTHR), LDS_BYTES, stream, a); }
#endif
}
```

```cpp
#include <hip/hip_runtime.h>
#include <hip/hip_cooperative_groups.h>
#include <cstdio>
#include <cstdint>
namespace cg = cooperative_groups;
namespace pg8 {
#define PG8_LAS __attribute__((address_space(3)))
typedef unsigned short bf16_t;
typedef short bf16x8 __attribute__((ext_vector_type(8)));
typedef float f32x4 __attribute__((ext_vector_type(4)));
typedef unsigned u32x4 __attribute__((ext_vector_type(4)));
constexpr int BM = 256, BK = 64, HALF = 128, HTB = HALF * BK * 2  , STAGE_BYTES = 8 * HTB, NXCD = 8, WGM = 8;

__host__ __device__ __forceinline__ int lds_byte(int r, int c) { const int st = (r >> 4) * 2 + (c >> 5), rr = r & 15, cc = c & 31, ob = rr * 64 + cc * 2; return st * 1024 + (ob ^ (((ob >> 9) & 1) << 5)); }
__host__ __device__ __forceinline__ void stage_rc(int b, int& R, int& C) { const int st = b / 1024, sb = b % 1024, swz = sb ^ (((sb >> 9) & 1) << 5); R = (st >> 1) * 16 + swz / 64; C = (st & 1) * 32 + (swz % 64) / 2; }
__host__ __device__ __forceinline__ int perm32(int rho) { const int n = rho >> 4, i = rho & 15; return 8 * (i >> 2) + 4 * n + (i & 3); }

struct Unit { int pm, pn; };
struct Gemm { const bf16_t* A; const bf16_t* Bt; int M, N, K; };

struct StaticOrder {
    int nM, nN, nwg, G, c;
    __host__ __device__ void init(int M, int N, int G_, int c_) { nM = M / BM; nN = N / BM; nwg = nM * nN; G = G_; c = c_; }
    __host__ __device__ bool next(int i, Unit& u) const {
        const long L = (long)i * G + c; if (L >= nwg) return false;
        int wgid = (int)L; { const int q = nwg / NXCD, r = nwg % NXCD, xcd = wgid % NXCD, off = wgid / NXCD; wgid = (xcd < r ? xcd * (q + 1) : r * (q + 1) + (xcd - r) * q) + off; }
        const int nig = WGM * nN, gid = wgid / nig, fm = gid * WGM, gsz = (nM - fm) < WGM ? (nM - fm) : WGM;
        u.pm = fm + ((wgid % nig) % gsz); u.pn = (wgid % nig) / gsz; return true;
    }
    __device__ __forceinline__ void a_ready(const Unit&) const {}
    __device__ __forceinline__ void done(const Unit&) const {}
};

__device__ __forceinline__ unsigned cvt_pk_bf16(float lo, float hi) { unsigned r; asm volatile("v_cvt_pk_bf16_f32 %0, %1, %2" : "=v"(r) : "v"(lo), "v"(hi)); return r; }
template <class Epi, class Sched, bool ALIGN_EPI = false, bool SP2 = false>
__device__ __forceinline__ void gemm_phase(PG8_LAS unsigned char* lds, const Gemm g, const Sched& S, const Epi& E) {
    const int tid = threadIdx.x, wid = __builtin_amdgcn_readfirstlane(tid >> 6), lane = tid & 63, wr = wid >> 2, wc = wid & 3, fr = lane & 15, fq = lane >> 4;
    const int K = g.K, nt = K / BK;
    unsigned voffA[2], voffB[2];
#pragma unroll
    for (int i = 0; i < 2; ++i) { int R, C; stage_rc(tid * 16 + i * 8192, R, C); const int Rb = Epi::PERM ? ((R & ~31) + perm32(R & 31)) : R;
        voffA[i] = (unsigned)(R * K + C) * 2u; voffB[i] = (unsigned)(Rb * K + C) * 2u; }
    const size_t kstep = (size_t)(BK * 2);
    const size_t hstep = (size_t)HALF * K * 2;
    const size_t tstep = 2 * hstep;
    const unsigned ldsw = (unsigned)wid * 1024u;
    const int aoff = lds_byte(wr * 64 + fr, fq * 8), boff = lds_byte(wc * 32 + fr, fq * 8);
#define PG8_SA(b, h) (((b) * 2 + (h)) * HTB)
#define PG8_SB(b, h) ((4 + (b) * 2 + (h)) * HTB)
#define PG8_STAGE(bufoff, gbase, voff) do { _Pragma("unroll") for (int _i = 0; _i < 2; ++_i) \
        __builtin_amdgcn_global_load_lds((const unsigned*)((const char*)(gbase) + (voff)[_i]), (PG8_LAS unsigned*)(lds + (bufoff) + ldsw + _i * 8192), 16, 0, 0); } while (0)
#define PG8_LDA(dst, b, h) do { _Pragma("unroll") for (int m = 0; m < 4; ++m) _Pragma("unroll") for (int k = 0; k < 2; ++k) dst[m][k] = *(const PG8_LAS bf16x8*)(lds + PG8_SA(b, h) + aoff + m * 2048 + k * 1024); } while (0)
#define PG8_LDB(dst, b, h) do { _Pragma("unroll") for (int n = 0; n < 2; ++n) _Pragma("unroll") for (int k = 0; k < 2; ++k) dst[n][k] = *(const PG8_LAS bf16x8*)(lds + PG8_SB(b, h) + boff + n * 2048 + k * 1024); } while (0)
#define PG8_MMA(ai, bj, At, Bt) do { __builtin_amdgcn_s_setprio(1); _Pragma("unroll") for (int m = 0; m < 4; ++m) _Pragma("unroll") for (int n = 0; n < 2; ++n) _Pragma("unroll") for (int k = 0; k < 2; ++k) \
        acc[ai][bj][m][n] = __builtin_amdgcn_mfma_f32_16x16x32_bf16(Bt[n][k], At[m][k], acc[ai][bj][m][n], 0, 0, 0); __builtin_amdgcn_s_setprio(0); } while (0)
#define PG8_WAIT_V(n) asm volatile("s_waitcnt vmcnt(" #n ")" ::: "memory")
#define PG8_WAIT_L(n) asm volatile("s_waitcnt lgkmcnt(" #n ")" ::: "memory")
#define PG8_BAR __builtin_amdgcn_s_barrier()
#define PG8_SCHED __builtin_amdgcn_sched_barrier(0)
    Unit cur, nxt; int ui = 0;
    if (!S.next(0, cur)) return;
    f32x4 acc[2][2][4][2];
#pragma unroll
    for (int a = 0; a < 2; ++a)
#pragma unroll
        for (int b = 0; b < 2; ++b)
#pragma unroll
            for (int m = 0; m < 4; ++m)
#pragma unroll
                for (int n = 0; n < 2; ++n) acc[a][b][m][n] = (f32x4){0.f, 0.f, 0.f, 0.f};
    bf16x8 At[4][2], B0[2][2], B1[2][2];
    const char* cA = (const char*)g.A + (size_t)cur.pm * tstep; const char* cB = (const char*)g.Bt + (size_t)cur.pn * tstep;
    S.a_ready(cur);
    if constexpr (SP2) {
        PG8_STAGE(PG8_SB(0, 0), cB, voffB); PG8_STAGE(PG8_SB(0, 1), cB + hstep, voffB); PG8_STAGE(PG8_SA(0, 0), cA, voffA); PG8_STAGE(PG8_SA(0, 1), cA + hstep, voffA);
        if (wr == 1) PG8_BAR;
        PG8_WAIT_V(2); PG8_BAR;
        PG8_STAGE(PG8_SB(1, 0), cB + kstep, voffB); PG8_STAGE(PG8_SA(1, 0), cA + kstep, voffA); PG8_STAGE(PG8_SB(1, 1), cB + hstep + kstep, voffB);
        PG8_WAIT_V(6); PG8_BAR;
    } else {
        PG8_STAGE(PG8_SB(0, 0), cB, voffB); PG8_STAGE(PG8_SA(0, 0), cA, voffA); PG8_STAGE(PG8_SB(0, 1), cB + hstep, voffB); PG8_STAGE(PG8_SA(0, 1), cA + hstep, voffA);
        if (wr == 1) PG8_BAR;
        PG8_WAIT_V(4); PG8_BAR;
        PG8_STAGE(PG8_SB(1, 0), cB + kstep, voffB); PG8_STAGE(PG8_SA(1, 0), cA + kstep, voffA); PG8_STAGE(PG8_SB(1, 1), cB + hstep + kstep, voffB);
        PG8_WAIT_V(6); PG8_BAR;
    }
    for (;;) {
        const bool has_next = S.next(ui + 1, nxt);
        const char* nA = has_next ? (const char*)g.A + (size_t)nxt.pm * tstep : cA; const char* nB = has_next ? (const char*)g.Bt + (size_t)nxt.pn * tstep : cB;
        for (int t = 0; t < nt; t += 2) {
            const bool last = (t == nt - 2);
            const char* a1 = cA + (size_t)(t + 1) * kstep;
            const char* a2 = last ? nA : cA + (size_t)(t + 2) * kstep; const char* b2 = last ? nB : cB + (size_t)(t + 2) * kstep;
            const char* a3 = a2 + kstep; const char* b3 = b2 + kstep;
            if (last && has_next) S.a_ready(nxt);
            if constexpr (SP2) {
            PG8_LDB(B0, 0, 0); PG8_LDB(B1, 0, 1); PG8_SCHED; PG8_LDA(At, 0, 0); PG8_STAGE(PG8_SA(1, 1), a1 + hstep, voffA);
            PG8_WAIT_V(8); PG8_WAIT_L(0); PG8_BAR; PG8_MMA(0, 0, At, B0); PG8_MMA(0, 1, At, B1); PG8_BAR; PG8_SCHED;
            PG8_LDA(At, 0, 1); PG8_STAGE(PG8_SB(0, 0), b2, voffB); PG8_STAGE(PG8_SB(0, 1), b2 + hstep, voffB); PG8_STAGE(PG8_SA(0, 0), a2, voffA);
            PG8_WAIT_V(8); PG8_WAIT_L(0); PG8_BAR; PG8_MMA(1, 0, At, B0); PG8_MMA(1, 1, At, B1); PG8_BAR; PG8_SCHED;
            PG8_LDB(B0, 1, 0); PG8_LDB(B1, 1, 1); PG8_SCHED; PG8_LDA(At, 1, 0); PG8_STAGE(PG8_SA(0, 1), a2 + hstep, voffA);
            PG8_WAIT_V(8); PG8_WAIT_L(0); PG8_BAR; PG8_MMA(0, 0, At, B0); PG8_MMA(0, 1, At, B1); PG8_BAR; PG8_SCHED;
            PG8_LDA(At, 1, 1); PG8_STAGE(PG8_SB(1, 0), b3, voffB); PG8_STAGE(PG8_SB(1, 1), b3 + hstep, voffB); PG8_STAGE(PG8_SA(1, 0), a3, voffA);
            PG8_WAIT_V(8); PG8_WAIT_L(0); PG8_BAR; PG8_MMA(1, 0, At, B0); PG8_MMA(1, 1, At, B1); PG8_BAR; PG8_SCHED;
            } else {
            PG8_LDB(B0, 0, 0); PG8_SCHED; PG8_LDA(At, 0, 0); PG8_STAGE(PG8_SA(1, 1), a1 + hstep, voffA);
            PG8_WAIT_L(8); PG8_BAR; PG8_WAIT_L(0); PG8_MMA(0, 0, At, B0); PG8_BAR; PG8_SCHED;
            PG8_LDB(B1, 0, 1); PG8_STAGE(PG8_SB(0, 0), b2, voffB);
            PG8_BAR; PG8_WAIT_L(0); PG8_MMA(0, 1, At, B1); PG8_BAR;
            PG8_LDA(At, 0, 1); PG8_STAGE(PG8_SA(0, 0), a2, voffA);
            PG8_BAR; PG8_WAIT_L(0); PG8_MMA(1, 0, At, B0); PG8_BAR; PG8_SCHED;
            PG8_STAGE(PG8_SB(0, 1), b2 + hstep, voffB);
            PG8_WAIT_V(6); PG8_BAR; PG8_MMA(1, 1, At, B1); PG8_BAR;
            PG8_LDB(B0, 1, 0); PG8_SCHED; PG8_LDA(At, 1, 0); PG8_STAGE(PG8_SA(0, 1), a2 + hstep, voffA);
            PG8_WAIT_L(8); PG8_BAR; PG8_WAIT_L(0); PG8_MMA(0, 0, At, B0); PG8_BAR; PG8_SCHED;
            PG8_LDB(B1, 1, 1); PG8_STAGE(PG8_SB(1, 0), b3, voffB);
            PG8_BAR; PG8_WAIT_L(0); PG8_MMA(0, 1, At, B1); PG8_BAR;
            PG8_LDA(At, 1, 1); PG8_STAGE(PG8_SA(1, 0), a3, voffA);
            PG8_BAR; PG8_WAIT_L(0); PG8_MMA(1, 0, At, B0); PG8_BAR; PG8_SCHED;
            PG8_STAGE(PG8_SB(1, 1), b3 + hstep, voffB);
            PG8_WAIT_V(6); PG8_BAR; PG8_MMA(1, 1, At, B1); PG8_BAR;
            }
        }
        if constexpr (ALIGN_EPI) { if (wr == 0) PG8_BAR; }
        if constexpr (!Epi::AFTER_DRAIN) { E(acc, cur, wr, wc, fr, fq); S.done(cur); }
        if (!has_next) break;
#pragma unroll
        for (int a = 0; a < 2; ++a)
#pragma unroll
            for (int b = 0; b < 2; ++b)
#pragma unroll
                for (int m = 0; m < 4; ++m)
#pragma unroll
                    for (int n = 0; n < 2; ++n) acc[a][b][m][n] = (f32x4){0.f, 0.f, 0.f, 0.f};
        cur = nxt; cA = nA; cB = nB; ++ui;
        if constexpr (ALIGN_EPI) { if (wr == 1) PG8_BAR; }
    }
    PG8_WAIT_V(0);
    if constexpr (!ALIGN_EPI) { if (wr == 0) PG8_BAR; }
    PG8_BAR;
    if constexpr (Epi::AFTER_DRAIN) { E.fused(acc, cur, wr, wc, fr, fq, lds, wid, lane); S.done(cur); }
#undef PG8_SA
#undef PG8_SB
#undef PG8_STAGE
#undef PG8_LDA
#undef PG8_LDB
#undef PG8_MMA
#undef PG8_WAIT_V
#undef PG8_WAIT_L
#undef PG8_BAR
#undef PG8_SCHED
}
}

#ifndef MK_ONE_LAUNCH
#define MK_ONE_LAUNCH 1
#endif
typedef unsigned short bf16;
typedef unsigned v4u __attribute__((ext_vector_type(4)));
typedef unsigned v2u __attribute__((ext_vector_type(2)));
typedef float f32x4 __attribute__((ext_vector_type(4)));
typedef short bf16x8 __attribute__((ext_vector_type(8)));

constexpr int NWAVES = 8, NTHR = 512;
constexpr int DM = 1024, NB = 4, SEQ = 4096, CTXL = 256;
constexpr int MLAT = NB * SEQ, MCTX = NB * CTXL, MTOT = MLAT + MCTX;
constexpr int PROJ = 5152, NPAD = 5376;
constexpr int NQL = 128, NQ = 136;
constexpr float EPS = 1e-6f;
constexpr size_t MiB = 1u << 20;
constexpr size_t WS_MODP = 1 * MiB, WS_GATE = 1 * MiB + 512 * 1024, WS_WIN = 2 * MiB, WS_WOUT = 14 * MiB, WS_HM = 18 * MiB, WS_PV = 52 * MiB,
                 WS_XBCR = 84 * MiB, WS_MIX = 148 * MiB, WS_PC = 212 * MiB, WS_DT = 216 * MiB, WS_XT = 219 * MiB, WS_CM = 18 * MiB, WS_ST = 52 * MiB, WS_END = 256 * MiB;
constexpr size_t DO_BM = 0, DO_BT = 17 * MiB, DO_AF = 34 * MiB, DO_RB = 36 * MiB, DO_DTF = 38 * MiB, DO_DTB = 40 * MiB;
constexpr int LDS_BYTES = 147456;

__device__ __forceinline__ float bf2f(unsigned short h) { return __uint_as_float((unsigned)h << 16); }
__device__ __forceinline__ float bflo(unsigned u) { return __uint_as_float(u << 16); }
__device__ __forceinline__ float bfhi(unsigned u) { return __uint_as_float(u & 0xffff0000u); }
__device__ __forceinline__ unsigned pk2(float lo, float hi) { return pg8::cvt_pk_bf16(lo, hi); }
__device__ __forceinline__ float silu_f(float x) { return x / (1.0f + __expf(-x)); }
__device__ __forceinline__ float wave_sum(float v) {
#pragma unroll
    for (int o = 1; o < 64; o <<= 1) v += __shfl_xor(v, o);
    return v;
}
#define MFMA16(a, b, c) __builtin_amdgcn_mfma_f32_16x16x32_bf16((a), (b), (c), 0, 0, 0)

struct Args {
    const float *x, *c, *ctx, *c_ctx, *norm_w, *w_ada, *b_ada, *w_in, *conv_w, *conv_b, *a_log, *dt_bias, *d_skip, *ssd_norm_w, *pool_w, *pool_scale, *w_out, *final_norm_w;
    float* out; unsigned char* ws; int ph_lo, ph_hi;
};

__device__ __forceinline__ void transpose_item(const float* W, int ldw, int n0, int k0, bf16* WT, int K, float* scr, int lane) {
#pragma unroll 8
    for (int i = 0; i < 32; ++i) { const int kk = 2 * i + (lane >> 5); scr[kk * 33 + (lane & 31)] = W[(size_t)(k0 + kk) * ldw + n0 + (lane & 31)]; }
    asm volatile("s_waitcnt lgkmcnt(0)" ::: "memory");
    const int c = lane & 7;
#pragma unroll
    for (int j = 0; j < 4; ++j) { const int n = (lane >> 3) + 8 * j; const float* s = scr + (8 * c) * 33 + n;
        v4u o; o.x = pk2(s[0 * 33], s[1 * 33]); o.y = pk2(s[2 * 33], s[3 * 33]); o.z = pk2(s[4 * 33], s[5 * 33]); o.w = pk2(s[6 * 33], s[7 * 33]);
        *(v4u*)(WT + (size_t)(n0 + n) * K + k0 + 8 * c) = o; }
    asm volatile("s_waitcnt lgkmcnt(0)" ::: "memory");
}

__device__ __forceinline__ void p0_prep(const Args& a, unsigned char* lds) {
    const int tid = threadIdx.x, lane = tid & 63, wave = tid >> 6, G = gridDim.x, bx = blockIdx.x;
    bf16* WIN = (bf16*)(a.ws + WS_WIN); bf16* WOUT = (bf16*)(a.ws + WS_WOUT); float* MODP = (float*)(a.ws + WS_MODP);
    {
        float* sv = (float*)lds;
        float* red = sv + 640;
        for (int it = bx; it < 192; it += G) {
            const int cb = it % 24, ks = it / 24, c0 = cb * 128, k0 = ks * 128;
            for (int i = tid; i < 640; i += NTHR) { const int r = i >> 7, k = i & 127; const float v = r < 4 ? a.c[r * DM + k0 + k] : a.c_ctx[k0 + k]; sv[i] = silu_f(v); }
            __syncthreads();
            const int col = tid & 127, kq = tid >> 7;
            float acc[5] = {0.f, 0.f, 0.f, 0.f, 0.f};
#pragma unroll 8
            for (int kk = 0; kk < 32; ++kk) { const int k = kq * 32 + kk; const float w = a.w_ada[(size_t)(k0 + k) * 3072 + c0 + col];
#pragma unroll
                for (int r = 0; r < 5; ++r) acc[r] += sv[r * 128 + k] * w; }
#pragma unroll
            for (int r = 0; r < 5; ++r) red[(kq * 5 + r) * 128 + col] = acc[r];
            __syncthreads();
            for (int i = tid; i < 640; i += NTHR) { const int r = i >> 7, cc = i & 127;
                MODP[(size_t)(ks * 5 + r) * 3072 + c0 + cc] = (red[(0 * 5 + r) * 128 + cc] + red[(1 * 5 + r) * 128 + cc]) + (red[(2 * 5 + r) * 128 + cc] + red[(3 * 5 + r) * 128 + cc]); }
            __syncthreads();
        }
    }
    {
        float* wl = (float*)lds;
        for (int it = bx; it < 256; it += G) {
            const int g = it >> 6, k0 = (it & 63) * 16;
#pragma unroll
            for (int j = 0; j < 8; ++j) { const int i = tid + j * NTHR, kk = i >> 8, cc = i & 255; wl[i] = a.w_in[(size_t)(k0 + kk) * PROJ + g * 256 + cc]; }
            __syncthreads();
            const int d = tid & 255, kh = tid >> 8;
            float acc[8] = {0.f, 0.f, 0.f, 0.f, 0.f, 0.f, 0.f, 0.f};
            const float* pw = a.pool_w + (size_t)g * 65536 + d;
#pragma unroll 4
            for (int cc = 0; cc < 256; ++cc) { const float p = pw[(size_t)cc * 256];
#pragma unroll
                for (int j = 0; j < 8; ++j) acc[j] += wl[(kh * 8 + j) * 256 + cc] * p; }
            v4u o; o.x = pk2(acc[0], acc[1]); o.y = pk2(acc[2], acc[3]); o.z = pk2(acc[4], acc[5]); o.w = pk2(acc[6], acc[7]);
            *(v4u*)(WIN + (size_t)(g * 256 + d) * DM + k0 + kh * 8) = o;
            __syncthreads();
        }
    }
    {
        float* scr = (float*)lds + wave * (64 * 33);
        const int gw = bx * NWAVES + wave, NGW = G * NWAVES;
        constexpr int I_IN = 16 * 129, I_OUT = 32 * 32;
        for (int it = gw; it < I_IN + I_OUT; it += NGW) {
            if (it < I_IN) { const int kb = it / 129, nb = it % 129; transpose_item(a.w_in, PROJ, 1024 + 32 * nb, 64 * kb, WIN, DM, scr, lane); }
            else { const int r = it - I_IN, kb = r >> 5, nb = r & 31; transpose_item(a.w_out, DM, 32 * nb, 64 * kb, WOUT, 2048, scr, lane); }
        }
        v4u z = {0u, 0u, 0u, 0u};
        v4u* zp = (v4u*)(WIN + (size_t)PROJ * DM);
        for (int i = bx * NTHR + tid; i < (NPAD - PROJ) * DM / 8; i += G * NTHR) zp[i] = z;
    }
    __syncthreads();
}

__device__ __forceinline__ void p1_hm(const Args& a, unsigned char* lds) {
    const int tid = threadIdx.x, lane = tid & 63, wave = tid >> 6, G = gridDim.x, bx = blockIdx.x;
    const float* MODP = (const float*)(a.ws + WS_MODP); float* GATE = (float*)(a.ws + WS_GATE); bf16* HM = (bf16*)(a.ws + WS_HM);
    float* sA = (float*)lds; float* sB = sA + 1024;
    for (int i = bx * NTHR + tid; i < 4096; i += G * NTHR) { const int bi = i >> 10, k = i & 1023; float g = a.b_ada[2048 + k];
        for (int s = 0; s < 8; ++s) g += MODP[(size_t)(s * 5 + bi) * 3072 + 2048 + k];
        GATE[i] = g; }
    for (int grp = bx; grp < 256; grp += G) {
        const int bi = grp >> 6;
        __syncthreads();
        for (int k = tid; k < 1024; k += NTHR) { float sh = a.b_ada[k], sc = a.b_ada[1024 + k], sh2 = sh, sc2 = sc;
#pragma unroll
            for (int s = 0; s < 8; ++s) { sh += MODP[(size_t)(s * 5 + bi) * 3072 + k]; sc += MODP[(size_t)(s * 5 + bi) * 3072 + 1024 + k];
                sh2 += MODP[(size_t)(s * 5 + 4) * 3072 + k]; sc2 += MODP[(size_t)(s * 5 + 4) * 3072 + 1024 + k]; }
            const float nw = a.norm_w[k];
            sA[k] = nw * (1.0f + sc); sB[k] = sh; sA[2048 + k] = nw * (1.0f + sc2); sB[2048 + k] = sh2; }
        __syncthreads();
        for (int rr = 0; rr < 9; ++rr) {
            int row, mo = 0;
            if (rr < 8) row = grp * 64 + wave * 8 + rr; else { if (wave >= 4) break; row = MLAT + grp * 4 + wave; mo = 2048; }
            const float* src = row < MLAT ? a.x + (size_t)row * DM : a.ctx + (size_t)(row - MLAT) * DM;
            const f32x4* xr = (const f32x4*)src + lane;
            f32x4 v[4]; float s = 0.f;
#pragma unroll
            for (int j = 0; j < 4; ++j) { v[j] = xr[64 * j]; s += (v[j].x * v[j].x + v[j].y * v[j].y) + (v[j].z * v[j].z + v[j].w * v[j].w); }
            const float rstd = rsqrtf(wave_sum(s) * (1.0f / DM) + EPS);
            v2u* o8 = (v2u*)(HM + (size_t)row * DM) + lane;
#pragma unroll
            for (int j = 0; j < 4; ++j) { const int k = 4 * (lane + 64 * j); const f32x4 ga = *(const f32x4*)(sA + mo + k), gb = *(const f32x4*)(sB + mo + k);
                v2u o; o.x = pk2(v[j].x * rstd * ga.x + gb.x, v[j].y * rstd * ga.y + gb.y); o.y = pk2(v[j].z * rstd * ga.z + gb.z, v[j].w * rstd * ga.w + gb.w);
                o8[64 * j] = o; }
        }
    }
    __syncthreads();
}

struct SchedIn {
    pg8::StaticOrder S0; int G, c;
    __device__ void init(int G_, int c_) { S0.init(MLAT, NPAD, G_, c_); G = G_; c = c_; }
    __device__ bool next(int i, pg8::Unit& u) const {
        if (S0.next(i, u)) return true;
        const long L = (long)i * G + c - S0.nwg; if (L >= 36) return false;
        u.pm = 64 + (int)(L & 3); u.pn = 12 + (int)(L >> 2); return true;
    }
    __device__ __forceinline__ void a_ready(const pg8::Unit&) const {}
    __device__ __forceinline__ void done(const pg8::Unit&) const {}
};
__device__ __forceinline__ float softplus_f(float x) { return fmaxf(x, 0.f) + log1pf(__expf(-fabsf(x))); }
struct EpiIn {
    static constexpr bool PERM = true, AFTER_DRAIN = false;
    bf16 *PV, *MIX, *XBCR, *PC; float* DT; const float* dt_bias;
    __device__ __forceinline__ void operator()(const pg8::f32x4 (&acc)[2][2][4][2], const pg8::Unit& u, int wr, int wc, int fr, int fq) const {
        using namespace pg8;
        const int pn = u.pn;
        if (pn < 20) {
            bf16* base; int ldc, colt; int row0 = u.pm * BM + wr * 64 + fr;
            if (u.pm >= 64) { base = PC; ldc = 2048; colt = (pn - 12) * 256; row0 -= MLAT; }
            else if (pn < 4) { base = PV; ldc = 1024; colt = pn * 256; }
            else if (pn < 12) { base = MIX; ldc = 2048; colt = (pn - 4) * 256; }
            else { base = XBCR; ldc = 2048; colt = (pn - 12) * 256; }
            const int col0 = colt + wc * 32 + 8 * fq;
#pragma unroll
            for (int ai = 0; ai < 2; ++ai)
#pragma unroll
                for (int m = 0; m < 4; ++m) { bf16* rowp = base + (size_t)(row0 + ai * HALF + m * 16) * ldc + col0;
#pragma unroll
                    for (int bj = 0; bj < 2; ++bj) { const pg8::f32x4 v0 = acc[ai][bj][m][0], v1 = acc[ai][bj][m][1];
                        pg8::u32x4 w; w.x = cvt_pk_bf16(v0[0], v0[1]); w.y = cvt_pk_bf16(v0[2], v0[3]); w.z = cvt_pk_bf16(v1[0], v1[1]); w.w = cvt_pk_bf16(v1[2], v1[3]);
                        *(pg8::u32x4*)(rowp + bj * HALF) = w; } }
        } else if (wc == 0) {
            const int row0 = u.pm * BM + wr * 64 + fr, col0 = 8 * fq;
            const pg8::f32x4 b0 = *(const pg8::f32x4*)(dt_bias + col0), b1 = *(const pg8::f32x4*)(dt_bias + col0 + 4);
#pragma unroll
            for (int ai = 0; ai < 2; ++ai)
#pragma unroll
                for (int m = 0; m < 4; ++m) { float* rowp = DT + (size_t)(row0 + ai * HALF + m * 16) * 32 + col0;
                    const pg8::f32x4 v0 = acc[ai][0][m][0] + b0, v1 = acc[ai][0][m][1] + b1;
                    pg8::f32x4 o0, o1;
#pragma unroll
                    for (int j = 0; j < 4; ++j) { o0[j] = softplus_f(v0[j]); o1[j] = softplus_f(v1[j]); }
                    *(pg8::f32x4*)rowp = o0; *(pg8::f32x4*)(rowp + 4) = o1; }
        }
    }
};
struct EpiOut {
    static constexpr bool PERM = false, AFTER_DRAIN = false;
    const float* x; const float* gate; float* out;
    __device__ __forceinline__ void operator()(const pg8::f32x4 (&acc)[2][2][4][2], const pg8::Unit& u, int wr, int wc, int fr, int fq) const {
        using namespace pg8;
        const int row0 = u.pm * BM + wr * 64 + fr, col0 = u.pn * BM + wc * 32 + 4 * fq;
        const float* gb = gate + (size_t)(u.pm >> 4) * DM;
#pragma unroll
        for (int ai = 0; ai < 2; ++ai)
#pragma unroll
            for (int m = 0; m < 4; ++m) { const size_t off = (size_t)(row0 + ai * HALF + m * 16) * DM + col0;
#pragma unroll
                for (int bj = 0; bj < 2; ++bj)
#pragma unroll
                    for (int n = 0; n < 2; ++n) { const int cc = bj * HALF + n * 16; const pg8::f32x4 xv = *(const pg8::f32x4*)(x + off + cc), gv = *(const pg8::f32x4*)(gb + col0 + cc);
                        *(pg8::f32x4*)(out + off + cc) = xv + gv * acc[ai][bj][m][n]; } }
    }
};

__device__ __forceinline__ void p3_conv_unit(const Args& a, unsigned char* lds, int u) {
    const int tid = threadIdx.x;
    const int q = u >> 4, slab = u & 15, col0 = slab * 128;
    int seq_len, l0, rowbase; const bf16* src;
    if (q < NQL) { seq_len = SEQ; l0 = (q & 31) * 128; rowbase = (q >> 5) * SEQ; src = (const bf16*)(a.ws + WS_XBCR); }
    else { const int qq = q - NQL; seq_len = CTXL; l0 = (qq & 1) * 128; rowbase = (qq >> 1) * CTXL; src = (const bf16*)(a.ws + WS_PC); }
    bf16* R = (bf16*)lds;
    bf16* O = (bf16*)(lds + 33536);
    unsigned char* OT = lds + 33536 + 32768;
    for (int i = tid; i < 131 * 16; i += NTHR) { const int row = i >> 4, ck = i & 15, t = l0 - 2 + row;
        v4u v = {0u, 0u, 0u, 0u};
        if (t >= 0 && t < seq_len) v = *(const v4u*)(src + (size_t)(rowbase + t) * 2048 + col0 + ck * 8);
        *(v4u*)(R + row * 128 + ck * 8) = v; }
    __syncthreads();
    {
        const int ch = tid & 127, lq = tid >> 7;
        const float w0 = a.conv_w[0 * 2048 + col0 + ch], w1 = a.conv_w[1 * 2048 + col0 + ch], w2 = a.conv_w[2 * 2048 + col0 + ch], w3 = a.conv_w[3 * 2048 + col0 + ch], bs = a.conv_b[col0 + ch];
        const int lb = lq * 32;
        float r0 = bf2f(R[(lb + 0) * 128 + ch]), r1 = bf2f(R[(lb + 1) * 128 + ch]), r2 = bf2f(R[(lb + 2) * 128 + ch]);
#pragma unroll 4
        for (int l = lb; l < lb + 32; l += 2) {
            const float r3 = bf2f(R[(l + 3) * 128 + ch]), r4 = bf2f(R[(l + 4) * 128 + ch]);
            const float y0 = silu_f(bs + w0 * r0 + w1 * r1 + w2 * r2 + w3 * r3);
            const float y1 = silu_f(bs + w0 * r1 + w1 * r2 + w2 * r3 + w3 * r4);
            const unsigned pk = pk2(y0, y1);
            O[l * 128 + ch] = (bf16)(pk & 0xffffu); O[(l + 1) * 128 + ch] = (bf16)(pk >> 16);
            *(unsigned*)(OT + ch * 260 + l * 2) = pk;
            r0 = r2; r1 = r3; r2 = r4;
        }
    }
    __syncthreads();
    if (slab >= 8) {
        const int g = slab & 3;
        bf16* dst = (slab < 12 ? (bf16*)((unsigned char*)a.out + DO_BM) : (bf16*)(a.ws + WS_CM)) + (size_t)(q * 4 + g) * 16384;
#pragma unroll
        for (int j = 0; j < 4; ++j) { const int i = tid + j * NTHR; *(v4u*)(dst + i * 8) = *(const v4u*)(O + i * 8); }
    }
    if (slab < 12) {
        unsigned* dst = slab < 8 ? (unsigned*)((bf16*)(a.ws + WS_XT) + (size_t)(q * 16 + 2 * slab) * 8192) : (unsigned*)((bf16*)((unsigned char*)a.out + DO_BT) + (size_t)(q * 4 + (slab - 8)) * 16384);
#pragma unroll
        for (int j = 0; j < 16; ++j) { const int i = tid + j * NTHR, row = i >> 6, dw = i & 63; dst[i] = *(const unsigned*)(OT + row * 260 + dw * 4); }
    }
    __syncthreads();
}

template <int HW>
__device__ __forceinline__ void pool_group(const Args& a, float* CM, int b, int r, int g, int co, int c4) {
    const bf16* PV = (const bf16*)(a.ws + WS_PV); bf16* MIX = (bf16*)(a.ws + WS_MIX);
    constexpr int NR = 2 * HW, BATCH = NR < 4 ? NR : 4;
    float acc[4][8];
#pragma unroll
    for (int ci = 0; ci < 4; ++ci)
#pragma unroll
        for (int e = 0; e < 8; ++e) acc[ci][e] = 0.f;
    const bf16* pbase = PV + (size_t)(b * SEQ + c4) * 1024 + g * 256 + co * 8;
#pragma unroll 1
    for (int k0 = 0; k0 < NR; k0 += BATCH) {
        v4u v[BATCH][4];
#pragma unroll
        for (int k = 0; k < BATCH; ++k) { const int rr = r - HW + k0 + k; const bool ok = rr >= 0 && rr < 64;
#pragma unroll
            for (int ci = 0; ci < 4; ++ci) { v[k][ci] = (v4u){0u, 0u, 0u, 0u}; if (ok) v[k][ci] = *(const v4u*)(pbase + (size_t)(rr * 64 + ci) * 1024); } }
#pragma unroll
        for (int k = 0; k < BATCH; ++k)
#pragma unroll
            for (int ci = 0; ci < 4; ++ci) { const v4u w = v[k][ci];
                acc[ci][0] += bflo(w.x); acc[ci][1] += bfhi(w.x); acc[ci][2] += bflo(w.y); acc[ci][3] += bfhi(w.y);
                acc[ci][4] += bflo(w.z); acc[ci][5] += bfhi(w.z); acc[ci][6] += bflo(w.w); acc[ci][7] += bfhi(w.w); }
    }
    const int r_lo = max(r - HW, 0), r_hi = min(r + HW, 64);
    const float inv1 = 1.0f / (float)(r_hi - r_lo);
#pragma unroll
    for (int ci = 0; ci < 4; ++ci) { f32x4 o0 = {acc[ci][0] * inv1, acc[ci][1] * inv1, acc[ci][2] * inv1, acc[ci][3] * inv1}, o1 = {acc[ci][4] * inv1, acc[ci][5] * inv1, acc[ci][6] * inv1, acc[ci][7] * inv1};
        *(f32x4*)(CM + (c4 + ci) * 256 + co * 8) = o0; *(f32x4*)(CM + (c4 + ci) * 256 + co * 8 + 4) = o1; }
    __syncthreads();
    {
        f32x4 s0 = {0.f, 0.f, 0.f, 0.f}, s1 = {0.f, 0.f, 0.f, 0.f};
        int lo = max(c4 - HW, 0), hi = min(c4 + HW, 64);
        for (int cc = lo; cc < hi; ++cc) { s0 += *(const f32x4*)(CM + cc * 256 + co * 8); s1 += *(const f32x4*)(CM + cc * 256 + co * 8 + 4); }
        const f32x4 ps0 = *(const f32x4*)(a.pool_scale + g * 256 + co * 8), ps1 = *(const f32x4*)(a.pool_scale + g * 256 + co * 8 + 4);
#pragma unroll
        for (int ci = 0; ci < 4; ++ci) {
            const int c = c4 + ci;
            if (ci > 0) { const int nlo = max(c - HW, 0), nhi = min(c + HW, 64);
                if (nhi > hi) { s0 += *(const f32x4*)(CM + hi * 256 + co * 8); s1 += *(const f32x4*)(CM + hi * 256 + co * 8 + 4); }
                if (nlo > lo) { s0 -= *(const f32x4*)(CM + lo * 256 + co * 8); s1 -= *(const f32x4*)(CM + lo * 256 + co * 8 + 4); }
                lo = nlo; hi = nhi; }
            const float inv2 = 1.0f / (float)(hi - lo);
            const size_t tok = (size_t)(b * SEQ + r * 64 + c);
            const v4u vv = *(const v4u*)(PV + tok * 1024 + g * 256 + co * 8);
            v4u* zp = (v4u*)(MIX + tok * 2048 + g * 256 + co * 8);
            const v4u zz = *zp;
            float m[8] = {s0[0] * inv2, s0[1] * inv2, s0[2] * inv2, s0[3] * inv2, s1[0] * inv2, s1[1] * inv2, s1[2] * inv2, s1[3] * inv2};
            float v[8] = {bflo(vv.x), bfhi(vv.x), bflo(vv.y), bfhi(vv.y), bflo(vv.z), bfhi(vv.z), bflo(vv.w), bfhi(vv.w)};
            float z[8] = {bflo(zz.x), bfhi(zz.x), bflo(zz.y), bfhi(zz.y), bflo(zz.z), bfhi(zz.z), bflo(zz.w), bfhi(zz.w)};
            float ps[8] = {ps0[0], ps0[1], ps0[2], ps0[3], ps1[0], ps1[1], ps1[2], ps1[3]};
            float y[8];
#pragma unroll
            for (int e = 0; e < 8; ++e) y[e] = (m[e] - v[e]) * ps[e] * silu_f(z[e]);
            v4u o; o.x = pk2(y[0], y[1]); o.y = pk2(y[2], y[3]); o.z = pk2(y[4], y[5]); o.w = pk2(y[6], y[7]);
            *zp = o;
        }
    }
}
__device__ __forceinline__ void p3_pool_unit(const Args& a, unsigned char* lds, int u) {
    const int tid = threadIdx.x, b = u >> 6, r = u & 63, co = tid & 31, c4 = (tid >> 5) * 4;
    float* CM0 = (float*)lds; float* CM1 = CM0 + 64 * 256;
    __syncthreads();
    pool_group<1>(a, CM0, b, r, 0, co, c4);
    pool_group<2>(a, CM1, b, r, 1, co, c4);
    pool_group<4>(a, CM0, b, r, 2, co, c4);
    pool_group<8>(a, CM1, b, r, 3, co, c4);
    __syncthreads();
}

__device__ __forceinline__ void p3_cumsum_item(const Args& a, int it, int lane) {
    const int q = it >> 4, h = it & 15;
    const float* DT = (const float*)(a.ws + WS_DT);
    const float af = -__expf(a.a_log[h]), ab = -__expf(a.a_log[16 + h]);
    const int l0 = 2 * lane;
    const float dtf0 = DT[(size_t)(q * 128 + l0) * 32 + h], dtf1 = DT[(size_t)(q * 128 + l0 + 1) * 32 + h];
    const float dtb0 = DT[(size_t)(q * 128 + l0) * 32 + 16 + h], dtb1 = DT[(size_t)(q * 128 + l0 + 1) * 32 + 16 + h];
    const float v0 = dtf0 * af, v1 = dtf1 * af, w0 = dtb0 * ab, w1 = dtb1 * ab;
    float inc = v0 + v1, sinc = w0 + w1;
#pragma unroll
    for (int o = 1; o < 64; o <<= 1) { const float t = __shfl_up(inc, o); if (lane >= o) inc += t; const float s = __shfl_down(sinc, o); if (lane + o < 64) sinc += s; }
    const size_t base = (size_t)(q * 16 + h) * 128 + l0;
    float2 o;
    o.x = inc - v1; o.y = inc; *(float2*)((float*)((unsigned char*)a.out + DO_AF) + base) = o;
    o.x = sinc; o.y = sinc - w0; *(float2*)((float*)((unsigned char*)a.out + DO_RB) + base) = o;
    o.x = dtf0; o.y = dtf1; *(float2*)((float*)((unsigned char*)a.out + DO_DTF) + base) = o;
    o.x = dtb0; o.y = dtb1; *(float2*)((float*)((unsigned char*)a.out + DO_DTB) + base) = o;
}

__device__ __forceinline__ void p3_all(const Args& a, unsigned char* lds) {
    const int G = gridDim.x, bx = blockIdx.x, tid = threadIdx.x;
    constexpr int NCONV = NQ * 16, NPOOL = 256;
    for (int it = bx; it < NPOOL; it += G) p3_pool_unit(a, lds, it);
    for (int it = bx; it < NCONV; it += G) p3_conv_unit(a, lds, it);
    for (int it = bx * NWAVES + (tid >> 6); it < NQ * 16; it += G * NWAVES) p3_cumsum_item(a, it, tid & 63);
}

__device__ __forceinline__ void p4_states(const Args& a, unsigned char* lds) {
    const int tid = threadIdx.x, lane = tid & 63, wave = tid >> 6, G = gridDim.x, bx = blockIdx.x, r = lane & 15, qd = lane >> 4;
    const bf16* BT = (const bf16*)((unsigned char*)a.out + DO_BT); const bf16* XT = (const bf16*)(a.ws + WS_XT); bf16* ST = (bf16*)(a.ws + WS_ST);
    const float* AF = (const float*)((unsigned char*)a.out + DO_AF); const float* RB = (const float*)((unsigned char*)a.out + DO_RB);
    const float* DTF = (const float*)((unsigned char*)a.out + DO_DTF); const float* DTB = (const float*)((unsigned char*)a.out + DO_DTB);
    for (int u = bx; u < NQ * 4; u += G) {
        const int q = u >> 2, g = u & 3;
        __syncthreads();
        { const bf16* srcb = BT + (size_t)u * 16384;
#pragma unroll
          for (int j = 0; j < 4; ++j) { const int i = tid + j * NTHR, row = i >> 4, ck = i & 15; *(v4u*)(lds + row * 272 + ck * 16) = *(const v4u*)(srcb + row * 128 + ck * 8); } }
        __syncthreads();
        const int h = g * 4 + (wave >> 1), dir = wave & 1;
        const size_t vb = (size_t)(q * 16 + h) * 128;
        const float* cum = dir ? RB + vb : AF + vb; const float* dtv = dir ? DTB + vb : DTF + vb;
        const float cend = dir ? cum[0] : cum[127];
        f32x4 acc[8][4];
#pragma unroll
        for (int nt = 0; nt < 8; ++nt)
#pragma unroll
            for (int pt = 0; pt < 4; ++pt) acc[nt][pt] = (f32x4){0.f, 0.f, 0.f, 0.f};
        const bf16* xb = XT + (size_t)(q * 16 + h) * 8192;
#pragma unroll 1
        for (int ks = 0; ks < 4; ++ks) {
            const int lk = ks * 32 + qd * 8;
            float wg[8];
            { const f32x4 c0 = *(const f32x4*)(cum + lk), c1 = *(const f32x4*)(cum + lk + 4), d0 = *(const f32x4*)(dtv + lk), d1 = *(const f32x4*)(dtv + lk + 4);
#pragma unroll
              for (int j = 0; j < 4; ++j) { wg[j] = __expf(cend - c0[j]) * d0[j]; wg[4 + j] = __expf(cend - c1[j]) * d1[j]; } }
            bf16x8 xf[4];
#pragma unroll
            for (int pt = 0; pt < 4; ++pt) { const v4u v = *(const v4u*)(xb + (pt * 16 + r) * 128 + lk);
                v4u o; o.x = pk2(bflo(v.x) * wg[0], bfhi(v.x) * wg[1]); o.y = pk2(bflo(v.y) * wg[2], bfhi(v.y) * wg[3]); o.z = pk2(bflo(v.z) * wg[4], bfhi(v.z) * wg[5]); o.w = pk2(bflo(v.w) * wg[6], bfhi(v.w) * wg[7]);
                xf[pt] = __builtin_bit_cast(bf16x8, o); }
#pragma unroll
            for (int nt = 0; nt < 8; ++nt) { const bf16x8 bfrag = *(const bf16x8*)(lds + (nt * 16 + r) * 272 + lk * 2);
#pragma unroll
                for (int pt = 0; pt < 4; ++pt) acc[nt][pt] = MFMA16(bfrag, xf[pt], acc[nt][pt]); }
        }
        bf16* dst = ST + ((size_t)(q * 16 + h) * 2 + dir) * 8192;
#pragma unroll
        for (int nt = 0; nt < 8; ++nt)
#pragma unroll
            for (int pt = 0; pt < 4; ++pt) { v2u o; o.x = pk2(acc[nt][pt][0], acc[nt][pt][1]); o.y = pk2(acc[nt][pt][2], acc[nt][pt][3]);
                *(v2u*)(dst + (pt * 16 + r) * 128 + nt * 16 + qd * 4) = o; }
    }
    __syncthreads();
}

__device__ __forceinline__ void p5_scan(const Args& a) {
    const int G = gridDim.x;
    bf16* ST = (bf16*)(a.ws + WS_ST);
    const float* AF = (const float*)((unsigned char*)a.out + DO_AF); const float* RB = (const float*)((unsigned char*)a.out + DO_RB);
    for (int e = blockIdx.x * NTHR + threadIdx.x; e < NB * 16 * 2 * 64 * 16; e += G * NTHR) {
        const int n8 = e & 15, p = (e >> 4) & 63, dir = (e >> 10) & 1, h = (e >> 11) & 15, b = e >> 15;
        float hs[8] = {0.f, 0.f, 0.f, 0.f, 0.f, 0.f, 0.f, 0.f};
        const size_t eo = (size_t)dir * 8192 + p * 128 + n8 * 8;
        for (int s = 0; s < 2; ++s) {
            const int q = NQL + b * 2 + (dir ? 1 - s : s);
            const float cd = __expf(dir ? RB[(size_t)(q * 16 + h) * 128] : AF[(size_t)(q * 16 + h) * 128 + 127]);
            const v4u v = *(const v4u*)(ST + (size_t)(q * 16 + h) * 16384 + eo);
            hs[0] = hs[0] * cd + bflo(v.x); hs[1] = hs[1] * cd + bfhi(v.x); hs[2] = hs[2] * cd + bflo(v.y); hs[3] = hs[3] * cd + bfhi(v.y);
            hs[4] = hs[4] * cd + bflo(v.z); hs[5] = hs[5] * cd + bfhi(v.z); hs[6] = hs[6] * cd + bflo(v.w); hs[7] = hs[7] * cd + bfhi(v.w);
        }
#pragma unroll 1
        for (int s0 = 0; s0 < 32; s0 += 8) {
            v4u v[8]; float cd[8];
#pragma unroll
            for (int k = 0; k < 8; ++k) { const int q = b * 32 + (dir ? 31 - (s0 + k) : s0 + k);
                v[k] = *(const v4u*)(ST + (size_t)(q * 16 + h) * 16384 + eo);
                cd[k] = dir ? RB[(size_t)(q * 16 + h) * 128] : AF[(size_t)(q * 16 + h) * 128 + 127]; }
#pragma unroll
            for (int k = 0; k < 8; ++k) { const int q = b * 32 + (dir ? 31 - (s0 + k) : s0 + k);
                const float c = __expf(cd[k]);
                v4u o; o.x = pk2(hs[0], hs[1]); o.y = pk2(hs[2], hs[3]); o.z = pk2(hs[4], hs[5]); o.w = pk2(hs[6], hs[7]);
                *(v4u*)(ST + (size_t)(q * 16 + h) * 16384 + eo) = o;
                hs[0] = hs[0] * c + bflo(v[k].x); hs[1] = hs[1] * c + bfhi(v[k].x); hs[2] = hs[2] * c + bflo(v[k].y); hs[3] = hs[3] * c + bfhi(v[k].y);
                hs[4] = hs[4] * c + bflo(v[k].z); hs[5] = hs[5] * c + bfhi(v[k].z); hs[6] = hs[6] * c + bflo(v[k].w); hs[7] = hs[7] * c + bfhi(v[k].w); }
        }
    }
}

constexpr int P6_CM = 0, P6_BM = 34816, P6_XT = 69632, P6_HF = P6_XT + 17408, P6_HB = P6_HF + 17408, P6_VEC = P6_HB + 17408;
__device__ __forceinline__ void p6_out(const Args& a, unsigned char* lds) {
    const int tid = threadIdx.x, lane = tid & 63, wave = tid >> 6, G = gridDim.x, bx = blockIdx.x, r = lane & 15, qd = lane >> 4;
    const bf16* BMg = (const bf16*)((unsigned char*)a.out + DO_BM); const bf16* CMg = (const bf16*)(a.ws + WS_CM);
    const bf16* XT = (const bf16*)(a.ws + WS_XT); const bf16* ST = (const bf16*)(a.ws + WS_ST); bf16* MIX = (bf16*)(a.ws + WS_MIX);
    const float* AF = (const float*)((unsigned char*)a.out + DO_AF); const float* RB = (const float*)((unsigned char*)a.out + DO_RB);
    const float* DTF = (const float*)((unsigned char*)a.out + DO_DTF); const float* DTB = (const float*)((unsigned char*)a.out + DO_DTB);
    float* vec = (float*)(lds + P6_VEC);
    const int lrow = wave * 16 + r;
    for (int u = bx; u < NQL * 4; u += G) {
        const int q = u >> 2, g = u & 3;
        __syncthreads();
        { const bf16* sc = CMg + (size_t)u * 16384; const bf16* sb = BMg + (size_t)u * 16384;
#pragma unroll
          for (int j = 0; j < 4; ++j) { const int i = tid + j * NTHR, row = i >> 4, ck = i & 15;
              *(v4u*)(lds + P6_CM + row * 272 + ck * 16) = *(const v4u*)(sc + row * 128 + ck * 8);
              *(v4u*)(lds + P6_BM + row * 272 + ck * 16) = *(const v4u*)(sb + row * 128 + ck * 8); } }
        __syncthreads();
        f32x4 cb[8];
#pragma unroll
        for (int st = 0; st < 8; ++st) cb[st] = (f32x4){0.f, 0.f, 0.f, 0.f};
#pragma unroll 1
        for (int ks = 0; ks < 4; ++ks) { const bf16x8 cfr = *(const bf16x8*)(lds + P6_CM + lrow * 272 + (ks * 32 + qd * 8) * 2);
#pragma unroll
            for (int st = 0; st < 8; ++st) { const bf16x8 bfr = *(const bf16x8*)(lds + P6_BM + (st * 16 + r) * 272 + (ks * 32 + qd * 8) * 2); cb[st] = MFMA16(bfr, cfr, cb[st]); } }
        f32x4 yacc[4][4];
        const size_t tok = (size_t)q * 128 + lrow;
#pragma unroll
        for (int hl = 0; hl < 4; ++hl) {
            const int h = g * 4 + hl;
            __syncthreads();
            { const bf16* sx = XT + (size_t)(q * 16 + h) * 8192; const bf16* sf = ST + (size_t)(q * 16 + h) * 16384; const bf16* sbk = sf + 8192;
#pragma unroll
              for (int j = 0; j < 2; ++j) { const int i = tid + j * NTHR, row = i >> 4, ck = i & 15;
                  *(v4u*)(lds + P6_XT + row * 272 + ck * 16) = *(const v4u*)(sx + row * 128 + ck * 8);
                  *(v4u*)(lds + P6_HF + row * 272 + ck * 16) = *(const v4u*)(sf + row * 128 + ck * 8);
                  *(v4u*)(lds + P6_HB + row * 272 + ck * 16) = *(const v4u*)(sbk + row * 128 + ck * 8); }
              const size_t vb = (size_t)(q * 16 + h) * 128;
              { const int which = tid >> 7, l = tid & 127; const float* s = which == 0 ? AF : which == 1 ? RB : which == 2 ? DTF : DTB; vec[which * 128 + l] = s[vb + l]; } }
            __syncthreads();
            const float afl = vec[lrow], rbl = vec[128 + lrow];
#pragma unroll
            for (int st = 0; st < 8; ++st) {
                const int s0 = st * 16 + qd * 4;
                const f32x4 afs = *(const f32x4*)(vec + s0), rbs = *(const f32x4*)(vec + 128 + s0), dfs = *(const f32x4*)(vec + 256 + s0), dbs = *(const f32x4*)(vec + 384 + s0);
                float m[4];
#pragma unroll
                for (int jj = 0; jj < 4; ++jj) { const int s = s0 + jj;
                    float t = 0.f;
                    if (s <= lrow) t += __expf(afl - afs[jj]) * dfs[jj];
                    if (s >= lrow) t += __expf(rbl - rbs[jj]) * dbs[jj];
                    m[jj] = t * cb[st][jj]; }
                v2u o; o.x = pk2(m[0], m[1]); o.y = pk2(m[2], m[3]);
                *(v2u*)(lds + P6_BM + lrow * 272 + s0 * 2) = o;
            }
            asm volatile("s_waitcnt lgkmcnt(0)" ::: "memory");
            const float ef = __expf(afl), eb = __expf(rbl), dsk = a.d_skip[h];
#pragma unroll
            for (int pt = 0; pt < 4; ++pt)
#pragma unroll
                for (int jj = 0; jj < 4; ++jj) { const int p = pt * 16 + qd * 4 + jj; yacc[hl][pt][jj] = dsk * bf2f(*(const bf16*)(lds + P6_XT + p * 272 + lrow * 2)); }
#pragma unroll 1
            for (int ks = 0; ks < 4; ++ks) {
                const int ko = (ks * 32 + qd * 8) * 2;
                const v4u cr = *(const v4u*)(lds + P6_CM + lrow * 272 + ko);
                v4u t;
                t.x = pk2(bflo(cr.x) * ef, bfhi(cr.x) * ef); t.y = pk2(bflo(cr.y) * ef, bfhi(cr.y) * ef); t.z = pk2(bflo(cr.z) * ef, bfhi(cr.z) * ef); t.w = pk2(bflo(cr.w) * ef, bfhi(cr.w) * ef);
                const bf16x8 cff = __builtin_bit_cast(bf16x8, t);
                t.x = pk2(bflo(cr.x) * eb, bfhi(cr.x) * eb); t.y = pk2(bflo(cr.y) * eb, bfhi(cr.y) * eb); t.z = pk2(bflo(cr.z) * eb, bfhi(cr.z) * eb); t.w = pk2(bflo(cr.w) * eb, bfhi(cr.w) * eb);
                const bf16x8 cfb = __builtin_bit_cast(bf16x8, t);
                const bf16x8 mf = *(const bf16x8*)(lds + P6_BM + lrow * 272 + ko);
#pragma unroll
                for (int pt = 0; pt < 4; ++pt) yacc[hl][pt] = MFMA16(*(const bf16x8*)(lds + P6_XT + (pt * 16 + r) * 272 + ko), mf, yacc[hl][pt]);
#pragma unroll
                for (int pt = 0; pt < 4; ++pt) yacc[hl][pt] = MFMA16(*(const bf16x8*)(lds + P6_HF + (pt * 16 + r) * 272 + ko), cff, yacc[hl][pt]);
#pragma unroll
                for (int pt = 0; pt < 4; ++pt) yacc[hl][pt] = MFMA16(*(const bf16x8*)(lds + P6_HB + (pt * 16 + r) * 272 + ko), cfb, yacc[hl][pt]);
            }
        }
        float ss = 0.f;
        bf16* zrow = MIX + tok * 2048 + 1024 + g * 256;
#pragma unroll
        for (int hl = 0; hl < 4; ++hl)
#pragma unroll
            for (int pt = 0; pt < 4; ++pt) { const v2u zz = *(const v2u*)(zrow + hl * 64 + pt * 16 + qd * 4);
                const float z0 = bflo(zz.x), z1 = bfhi(zz.x), z2 = bflo(zz.y), z3 = bfhi(zz.y);
                f32x4 gv = yacc[hl][pt]; gv[0] *= silu_f(z0); gv[1] *= silu_f(z1); gv[2] *= silu_f(z2); gv[3] *= silu_f(z3);
                ss += (gv[0] * gv[0] + gv[1] * gv[1]) + (gv[2] * gv[2] + gv[3] * gv[3]); yacc[hl][pt] = gv; }
        ss += __shfl_xor(ss, 16); ss += __shfl_xor(ss, 32);
        const float rstd = rsqrtf(ss * (1.0f / 256.0f) + EPS);
        const float* nw = a.ssd_norm_w + g * 256;
#pragma unroll
        for (int hl = 0; hl < 4; ++hl)
#pragma unroll
            for (int pt = 0; pt < 4; ++pt) { const int cix = hl * 64 + pt * 16 + qd * 4; const f32x4 w = *(const f32x4*)(nw + cix); const f32x4 gv = yacc[hl][pt];
                v2u o; o.x = pk2(gv[0] * rstd * w[0], gv[1] * rstd * w[1]); o.y = pk2(gv[2] * rstd * w[2], gv[3] * rstd * w[3]);
                *(v2u*)(zrow + cix) = o; }
    }
    __syncthreads();
}

__device__ __forceinline__ void p8_final(const Args& a) {
    const int tid = threadIdx.x, lane = tid & 63, wave = tid >> 6, G = gridDim.x;
    for (int row = blockIdx.x * NWAVES + wave; row < MLAT; row += G * NWAVES) {
        f32x4* xr = (f32x4*)(a.out + (size_t)row * DM) + lane;
        f32x4 v[4]; float s = 0.f;
#pragma unroll
        for (int j = 0; j < 4; ++j) { v[j] = xr[64 * j]; s += (v[j].x * v[j].x + v[j].y * v[j].y) + (v[j].z * v[j].z + v[j].w * v[j].w); }
        const float rstd = rsqrtf(wave_sum(s) * (1.0f / DM) + EPS);
#pragma unroll
        for (int j = 0; j < 4; ++j) { const f32x4 w = *((const f32x4*)a.final_norm_w + lane + 64 * j); xr[64 * j] = v[j] * rstd * w; }
    }
}

#define LAS __attribute__((address_space(3)))
#define XB_TMO      128
#define XB_XCNT(j)  (256  + 64 * (j))
#define XB_XSUB(j)  (1280 + 64 * (j))
#define XB_XGEN(j)  (2304 + 64 * (j))
#define XB_TOP      3328
#define XB_TOPGEN   3392
#define XCD_BAR_WORDS 3456
#define XB_SPIN_CAP (1u << 18)

__device__ __forceinline__ unsigned xb_ld(unsigned* p)              { return __hip_atomic_load(p, __ATOMIC_RELAXED, __HIP_MEMORY_SCOPE_AGENT); }
__device__ __forceinline__ unsigned xb_add(unsigned* p, unsigned v) { return __hip_atomic_fetch_add(p, v, __ATOMIC_RELAXED, __HIP_MEMORY_SCOPE_AGENT); }
__device__ __forceinline__ unsigned xb_xcc_id() { return (unsigned)__builtin_amdgcn_s_getreg((3 << 11) | 20) & 0xFu; }
#define XB_SPIN(cond, bar) do { unsigned _sp = 0; while (cond) { __builtin_amdgcn_s_sleep(1); \
    if ((++_sp & 255u) == 0u) { if (xb_ld(&(bar)[XB_TMO])) break; if (_sp > XB_SPIN_CAP) { atomicAdd(&(bar)[XB_TMO], 1u); break; } } } } while (0)

struct XcdBarrier {
    unsigned* bar; unsigned x;
    volatile LAS unsigned* st;
};

__device__ __forceinline__ XcdBarrier xcd_barrier_post(unsigned* bar, volatile LAS unsigned* st) {
    XcdBarrier b; b.bar = bar; b.x = xb_xcc_id(); b.st = st;
    if (threadIdx.x == 0) (void)xb_add(&bar[XB_XCNT(b.x)], 1u);
    return b;
}
__device__ __forceinline__ void xcd_barrier_complete(unsigned* bar, unsigned x, unsigned& nloc, unsigned& nx) {
    const unsigned G = gridDim.x * gridDim.y * gridDim.z;
    unsigned sum, cnt, mine, sp = 0u;
    for (;;) {
        sum = 0u; cnt = 0u; mine = 0u;
#pragma unroll
        for (unsigned j = 0; j < 16; ++j) { const unsigned c = xb_ld(&bar[XB_XCNT(j)]); sum += c; cnt += (c > 0u) ? 1u : 0u; mine = (j == x) ? c : mine; }
        if (sum == G) break;
        __builtin_amdgcn_s_sleep(1);
        if ((++sp & 255u) == 0u) { if (xb_ld(&bar[XB_TMO])) break; if (sp > XB_SPIN_CAP) { atomicAdd(&bar[XB_TMO], 1u); break; } }
    }
    nloc = mine > 0u ? mine : 1u; nx = cnt > 0u ? cnt : 1u;
}

__device__ __forceinline__ void xcd_barrier(const XcdBarrier& b) {
    asm volatile("s_waitcnt vmcnt(0)" ::: "memory");
    __syncthreads();
    if (threadIdx.x == 0) {
        unsigned* bar = b.bar;
        __builtin_amdgcn_s_waitcnt(0);
        unsigned nloc = b.st[0], nx = b.st[1];
        if (nloc == 0u) { xcd_barrier_complete(bar, b.x, nloc, nx); b.st[0] = nloc; b.st[1] = nx; }
        const unsigned old = xb_add(&bar[XB_XSUB(b.x)], 1u);
        const unsigned gen = old / nloc;
        if (old + 1u == (gen + 1u) * nloc) {
            __builtin_amdgcn_fence(__ATOMIC_RELEASE, "agent");
            asm volatile("s_waitcnt vmcnt(0)" ::: "memory");
            const unsigned og = xb_add(&bar[XB_TOP], 1u);
            const unsigned tg = og / nx;
            if (og + 1u == (tg + 1u) * nx) xb_add(&bar[XB_TOPGEN], 1u);
            else XB_SPIN(xb_ld(&bar[XB_TOPGEN]) == tg, bar);
            __builtin_amdgcn_fence(__ATOMIC_ACQUIRE, "agent");
            xb_add(&bar[XB_XGEN(b.x)], 1u);
            asm volatile("s_waitcnt vmcnt(0)" ::: "memory");
        } else {
            XB_SPIN(xb_ld(&bar[XB_XGEN(b.x)]) == gen, bar);
            __builtin_amdgcn_fence(__ATOMIC_ACQUIRE, "agent");
            asm volatile("s_waitcnt vmcnt(0)" ::: "memory");
        }
    }
    __syncthreads();
}

constexpr int MISC_OFF = 131072 + 320;
__global__ void __launch_bounds__(NTHR, 2) fwd_kernel(Args args) {
    extern __shared__ __attribute__((aligned(16))) unsigned char lds[];
    cg::grid_group grid = cg::this_grid();
    const int lo = args.ph_lo, hi = args.ph_hi;
    volatile LAS unsigned* MISC = (volatile LAS unsigned*)((LAS unsigned char*)lds + MISC_OFF);
    if (threadIdx.x < 32) MISC[threadIdx.x] = 0u;
    __syncthreads();
    XcdBarrier bar; bar.bar = (unsigned*)args.ws; bar.x = 0; bar.st = nullptr;
    if (hi - lo > 1) bar = xcd_barrier_post((unsigned*)args.ws, MISC + 8);
    if (lo < 0) grid.sync();
#define IN(k) (lo <= (k) && (k) < hi)
#define SEAM(k) do { if (IN(k) && IN((k) + 1)) xcd_barrier(bar); } while (0)

#ifndef SKIP_P0
    if (IN(0)) p0_prep(args, lds);
#endif

    SEAM(0);

#ifndef SKIP_P1
    if (IN(1)) p1_hm(args, lds);
#endif

    SEAM(1);
#ifndef SKIP_P2
    if (IN(2)) {
        pg8::Gemm g{(const pg8::bf16_t*)(args.ws + WS_HM), (const pg8::bf16_t*)(args.ws + WS_WIN), MTOT, NPAD, DM};
        SchedIn S; S.init((int)gridDim.x, (int)blockIdx.x);
        EpiIn E{(bf16*)(args.ws + WS_PV), (bf16*)(args.ws + WS_MIX), (bf16*)(args.ws + WS_XBCR), (bf16*)(args.ws + WS_PC), (float*)(args.ws + WS_DT), args.dt_bias};
        pg8::gemm_phase<EpiIn, SchedIn, true, true>((PG8_LAS unsigned char*)lds, g, S, E);
    }
#endif
    SEAM(2);

#ifndef SKIP_P3
    if (IN(3)) p3_all(args, lds);
#endif

    SEAM(3);

#ifndef SKIP_P4
    if (IN(4)) p4_states(args, lds);
#endif

    SEAM(4);

#ifndef SKIP_P5
    if (IN(5)) p5_scan(args);
#endif

    SEAM(5);

#ifndef SKIP_P6
    if (IN(6)) p6_out(args, lds);
#endif

    SEAM(6);
#ifndef SKIP_P7
    if (IN(7)) {
        pg8::Gemm g{(const pg8::bf16_t*)(args.ws + WS_MIX), (const pg8::bf16_t*)(args.ws + WS_WOUT), MLAT, DM, 2048};
        pg8::StaticOrder S; S.init(MLAT, DM, (int)gridDim.x, (int)blockIdx.x);
        EpiOut E{args.x, (const float*)(args.ws + WS_GATE), args.out};
        pg8::gemm_phase<EpiOut, pg8::StaticOrder, true, true>((PG8_LAS unsigned char*)lds, g, S, E);
    }
#endif
    SEAM(7);

#ifndef SKIP_P8
    if (IN(8)) p8_final(args);
#endif

#undef IN
#undef SEAM
}

extern "C" void kernel_launch(void* const* d_in, const int* in_sizes, int n_in, void* d_out, int out_size, void* d_ws, size_t ws_size, hipStream_t stream) {
    static int grid = 0;
    if (grid == 0) {
        if (n_in != 18 || out_size != MLAT * DM || ws_size < WS_END) { fprintf(stderr, "kernel_launch: unexpected shapes (n_in %d out %d ws %zu)\n", n_in, out_size, ws_size); grid = -1; return; }
        int dev = 0, cus = 0, per_cu = 0;
        hipGetDevice(&dev); hipDeviceGetAttribute(&cus, hipDeviceAttributeMultiprocessorCount, dev);
        if (hipFuncSetAttribute((const void*)fwd_kernel, hipFuncAttributeMaxDynamicSharedMemorySize, LDS_BYTES) != hipSuccess) { fprintf(stderr, "kernel_launch: hipFuncSetAttribute failed\n"); grid = -1; return; }
        if (hipOccupancyMaxActiveBlocksPerMultiprocessor(&per_cu, (const void*)fwd_kernel, NTHR, LDS_BYTES) != hipSuccess || per_cu < 1) { fprintf(stderr, "kernel_launch: occupancy query failed (%d)\n", per_cu); (void)hipGetLastError(); per_cu = 1; }
        grid = cus * (per_cu > 1 ? 1 : per_cu);
    }
    if (grid < 0) return;
    Args a{};
    const float** ap = (const float**)&a;
    for (int i = 0; i < 18; ++i) ap[i] = (const float*)d_in[i];
    a.out = (float*)d_out; a.ws = (unsigned char*)d_ws;
#if MK_ONE_LAUNCH
    if (hipMemsetAsync(d_ws, 0, 16384, stream) != hipSuccess) { fprintf(stderr, "kernel_launch: memset failed\n"); return; }
    a.ph_lo = 0; a.ph_hi = 9;
    void* kargs[] = {&a};
    hipError_t e = hipLaunchCooperativeKernel((const void*)fwd_kernel, dim3(grid), dim3(NTHR), kargs, LDS_BYTES, stream);
    if (e != hipSuccess) fprintf(stderr, "cooperative launch failed: %s (grid %d)\n", hipGetErrorString(e), grid);
#else
#ifndef MK_SEQ
#define MK_SEQ 0, 1, 2, 3, 4, 5, 6, 7, 8
#endif
    const int seq[] = {MK_SEQ};
    for (int i = 0; i < (int)(sizeof(seq) / sizeof(int)); ++i) { a.ph_lo = seq[i]; a.ph_hi = seq[i] + 1; hipLaunchKernelGGL(fwd_kernel, dim3(grid), dim3(NTHR), LDS_BYTES, stream, a); }
#endif
}
```
